# Optimizing an MI355X kernel written in HIP

```python
import math
import jax, jax.numpy as jnp
from jax import lax
import numpy as np

D_MODEL = 1024
BATCH = 16
SEQ = 2048
DEPTH = 2

HEAD_DIM = 64
H_SB = 4
H_DSA = 4
H_IDX = 4
D_IDX = 64
TOPK_MAX = 256
H_SW = 8
KV_SW = 2
WINDOW = 128
BLOCK = 128
N_BRANCH = 3
N_BUCKETS = 32
MAX_DISTANCE = 128
N_MEM = 256
H_X = 4
XHEAD_DIM = 128
D_FF_DENSE = (11 * D_MODEL) // 4
N_EXPERTS = 8
TOP_K_EXPERTS = 2
D_FF_EXPERT = (7 * D_MODEL) // 2
N_DENSE_LAYERS = (DEPTH + 1) // 2
N_MOE_LAYERS = DEPTH // 2
EPS = 1e-6

IN_SIZES = (
    H_SB * HEAD_DIM, H_SB * HEAD_DIM, H_SB * HEAD_DIM,
    H_DSA * HEAD_DIM, HEAD_DIM, HEAD_DIM,
    H_IDX * D_IDX, D_IDX, H_IDX,
    H_SW * HEAD_DIM, KV_SW * HEAD_DIM, KV_SW * HEAD_DIM,
    N_BRANCH * D_MODEL,
)
N_IN = sum(IN_SIZES)

kernel_name = 'hybrid_gated_sb_dsa_swa_moe'


def rmsnorm(x, g):
    xf = x.astype(jnp.float32)
    y = xf * lax.rsqrt(jnp.mean(xf * xf, axis=-1, keepdims=True) + EPS)
    return (y * g.astype(jnp.float32)).astype(x.dtype)


def _split(t, sizes):
    return jnp.split(t, np.cumsum(sizes)[:-1].tolist(), axis=-1)


def t5_bucket(rel):
    n = jnp.maximum(rel, 0)
    max_exact = N_BUCKETS // 2
    nf = jnp.maximum(n, 1).astype(jnp.float32)
    large = max_exact + (jnp.log(nf / max_exact) / math.log(MAX_DISTANCE / max_exact)
                         * (N_BUCKETS - max_exact)).astype(jnp.int32)
    large = jnp.minimum(large, N_BUCKETS - 1)
    return jnp.where(n < max_exact, n, large)


def stick_breaking_attention(q, k, v):
    B_, S_, H, d = q.shape
    nblk = S_ // BLOCK
    scale = d ** -0.5
    kpos = jnp.arange(S_)

    def block(i):
        q0 = i * BLOCK
        qpos = q0 + jnp.arange(BLOCK)
        q_blk = lax.dynamic_slice_in_dim(q, q0, BLOCK, axis=1)
        z = jnp.einsum('bthd,bshd->bhts', q_blk, k, preferred_element_type=jnp.float32) * scale
        causal = kpos[None, :] < qpos[:, None]
        log_beta = jax.nn.log_sigmoid(z)
        log_keep = jnp.where(causal, jax.nn.log_sigmoid(-z), 0.0)
        rev = lax.cumsum(log_keep, axis=3, reverse=True) - log_keep
        att = jnp.where(causal, jnp.exp(log_beta + rev), 0.0)
        return jnp.einsum('bhts,bshd->bthd', att.astype(v.dtype), v)

    out = lax.map(block, jnp.arange(nblk))
    return out.transpose(1, 0, 2, 3, 4).reshape(B_, S_, H, d)


def dsa_attention(q, k, v, q_idx, k_idx, w_idx, bias_tab):
    B_, S_, H, d = q.shape
    topk = min(TOPK_MAX, S_ // 4)
    nblk = S_ // BLOCK
    kpos = jnp.arange(S_)
    gather = jax.vmap(lambda t, i: t[i])

    def block(i):
        q0 = i * BLOCK
        qpos = q0 + jnp.arange(BLOCK)
        q_blk = lax.dynamic_slice_in_dim(q, q0, BLOCK, axis=1)
        qi_blk = lax.dynamic_slice_in_dim(q_idx, q0, BLOCK, axis=1)
        wi_blk = lax.dynamic_slice_in_dim(w_idx, q0, BLOCK, axis=1)
        act = jax.nn.relu(jnp.einsum('bthe,bse->bths', qi_blk, k_idx,
                                     preferred_element_type=jnp.float32) * D_IDX ** -0.5)
        score = jnp.einsum('bth,bths->bts', wi_blk.astype(jnp.float32), act)
        score = jnp.where(kpos[None, None, :] <= qpos[None, :, None], score, -jnp.inf)
        _, idx = lax.top_k(score, topk)
        valid = idx <= qpos[None, :, None]
        k_sel = gather(k, idx)
        v_sel = gather(v, idx)
        s = jnp.einsum('bthd,btkd->bhtk', q_blk, k_sel, preferred_element_type=jnp.float32) * d ** -0.5
        bias = bias_tab[t5_bucket(qpos[None, :, None] - idx)]
        s = s + bias.transpose(0, 3, 1, 2).astype(jnp.float32)
        s = jnp.where(valid[:, None], s, -jnp.inf)
        p = jax.nn.softmax(s, axis=-1)
        return jnp.einsum('bhtk,btkd->bthd', p.astype(v.dtype), v_sel)

    out = lax.map(block, jnp.arange(nblk))
    return out.transpose(1, 0, 2, 3, 4).reshape(B_, S_, H, d)


def sliding_window_attention(q, k, v, sinks, bias_tab):
    B_, S_, H, d = q.shape
    G = H // KV_SW
    nblk = S_ // BLOCK
    qb = q.reshape(B_, nblk, BLOCK, KV_SW, G, d)
    kb = k.reshape(B_, nblk, BLOCK, KV_SW, d)
    vb = v.reshape(B_, nblk, BLOCK, KV_SW, d)
    pad = jnp.zeros_like(kb[:, :1])
    k2 = jnp.concatenate([jnp.concatenate([pad, kb[:, :-1]], axis=1), kb], axis=2)
    v2 = jnp.concatenate([jnp.concatenate([pad, vb[:, :-1]], axis=1), vb], axis=2)
    s = jnp.einsum('bnqkgd,bnjkd->bnkgqj', qb, k2, preferred_element_type=jnp.float32) * d ** -0.5
    kj = jnp.arange(2 * BLOCK)[None, :]
    rel = (jnp.arange(BLOCK)[:, None] + BLOCK) - kj
    in_win = (rel >= 0) & (rel < WINDOW)
    has_prev = (jnp.arange(nblk)[:, None, None] > 0) | (kj[None] >= BLOCK)
    mask = in_win[None] & has_prev
    bias = bias_tab[t5_bucket(rel)].transpose(2, 0, 1).reshape(KV_SW, G, BLOCK, 2 * BLOCK)
    s = s + bias[None, None].astype(jnp.float32)
    s = jnp.where(mask[None, :, None, None], s, -jnp.inf)
    sink = sinks.astype(jnp.float32).reshape(KV_SW, G)[None, None, :, :, None, None]
    m = jnp.maximum(jnp.max(s, axis=-1, keepdims=True), sink)
    e = jnp.exp(s - m)
    p = e / (jnp.sum(e, axis=-1, keepdims=True) + jnp.exp(sink - m))
    o = jnp.einsum('bnkgqj,bnjkd->bnqkgd', p.astype(v.dtype), v2)
    return o.reshape(B_, S_, H, d)


def cross_attention(xn, memn, w_q, w_kv, w_o, q_gain, k_gain):
    B_, S_, _ = xn.shape
    M = memn.shape[1]
    q = rmsnorm((xn @ w_q).reshape(B_, S_, H_X, XHEAD_DIM), q_gain)
    k, v = _split(memn @ w_kv, (H_X * XHEAD_DIM, H_X * XHEAD_DIM))
    k = rmsnorm(k.reshape(B_, M, H_X, XHEAD_DIM), k_gain)
    v = v.reshape(B_, M, H_X, XHEAD_DIM)
    s = jnp.einsum('bshd,bmhd->bhsm', q, k, preferred_element_type=jnp.float32) * XHEAD_DIM ** -0.5
    p = jax.nn.softmax(s, axis=-1)
    o = jnp.einsum('bhsm,bmhd->bshd', p.astype(v.dtype), v)
    return o.reshape(B_, S_, H_X * XHEAD_DIM) @ w_o


def swiglu(h, w_gu, w_down):
    g, u = jnp.split(h @ w_gu, 2, axis=-1)
    return (jax.nn.silu(g) * u) @ w_down


def moe_swiglu(h, w_router, w_gu, w_down):
    B_, S_, D = h.shape
    t = h.reshape(-1, D)
    logits = jnp.dot(t, w_router, preferred_element_type=jnp.float32)
    top_val, top_idx = lax.top_k(logits, TOP_K_EXPERTS)
    top_gate = jax.nn.softmax(top_val, axis=-1)
    gate = jnp.sum(jax.nn.one_hot(top_idx, N_EXPERTS, dtype=jnp.float32) * top_gate[..., None], axis=1)
    out = jnp.zeros(t.shape, jnp.float32)
    for e in range(N_EXPERTS):
        out = out + gate[:, e:e + 1] * swiglu(t, w_gu[e], w_down[e]).astype(jnp.float32)
    return out.astype(h.dtype).reshape(B_, S_, D)


def setup_inputs(seed: int = 0) -> dict:
    key = jax.random.key(seed)
    ks = iter(jax.random.split(key, 32))
    D = D_MODEL

    def nrm(shape, scale):
        return jax.random.normal(next(ks), shape, jnp.float32) * scale

    def gain(shape):
        return 1.0 + nrm(shape, 0.02)

    w_a = H_SB * HEAD_DIM
    w_b = H_DSA * HEAD_DIM
    w_c = H_SW * HEAD_DIM
    w_x = H_X * XHEAD_DIM
    return {
        'x': nrm((BATCH, SEQ, D), 1.0),
        'mem': nrm((BATCH, N_MEM, D), 1.0),
        'rel_bias': nrm((N_BUCKETS, H_DSA + H_SW), 0.2),
        'norm_mix': gain((DEPTH, D)),
        'w_in': nrm((DEPTH, D, N_IN), D ** -0.5),
        'b_gate': nrm((DEPTH, N_BRANCH, D), 0.02),
        'qn_dsa': gain((DEPTH, HEAD_DIM)),
        'kn_dsa': gain((DEPTH, HEAD_DIM)),
        'qn_swa': gain((DEPTH, HEAD_DIM)),
        'kn_swa': gain((DEPTH, HEAD_DIM)),
        'sinks': nrm((DEPTH, H_SW), 0.5),
        'w_pa': nrm((DEPTH, w_a, D), w_a ** -0.5),
        'w_pb': nrm((DEPTH, w_b, D), w_b ** -0.5),
        'w_pc': nrm((DEPTH, w_c, D), w_c ** -0.5),
        'w_out': nrm((DEPTH, D, D), D ** -0.5),
        'norm_x': gain((DEPTH, D)),
        'norm_mem': gain((DEPTH, D)),
        'w_xq': nrm((DEPTH, D, w_x), D ** -0.5),
        'w_xkv': nrm((DEPTH, D, 2 * w_x), D ** -0.5),
        'w_xo': nrm((DEPTH, w_x, D), w_x ** -0.5),
        'qn_x': gain((DEPTH, XHEAD_DIM)),
        'kn_x': gain((DEPTH, XHEAD_DIM)),
        'norm_ffn': gain((DEPTH, D)),
        'w_gu_dense': nrm((N_DENSE_LAYERS, D, 2 * D_FF_DENSE), D ** -0.5),
        'w_down_dense': nrm((N_DENSE_LAYERS, D_FF_DENSE, D), D_FF_DENSE ** -0.5),
        'w_router': nrm((N_MOE_LAYERS, D, N_EXPERTS), D ** -0.5),
        'w_gu_moe': nrm((N_MOE_LAYERS, N_EXPERTS, D, 2 * D_FF_EXPERT), D ** -0.5),
        'w_down_moe': nrm((N_MOE_LAYERS, N_EXPERTS, D_FF_EXPERT, D), D_FF_EXPERT ** -0.5),
    }


def reference(x, mem, rel_bias, norm_mix, w_in, b_gate, qn_dsa, kn_dsa, qn_swa, kn_swa, sinks,
              w_pa, w_pb, w_pc, w_out, norm_x, norm_mem, w_xq, w_xkv, w_xo, qn_x, kn_x,
              norm_ffn, w_gu_dense, w_down_dense, w_router, w_gu_moe, w_down_moe):
    B_, S_, D = x.shape
    bias_dsa = rel_bias[:, :H_DSA]
    bias_swa = rel_bias[:, H_DSA:]

    def heads(t, n, d):
        return t.reshape(B_, S_, n, d)

    for l in range(DEPTH):
        h = rmsnorm(x, norm_mix[l])
        qa, ka, va, qb, kb, vb, qi, ki, wi, qc, kc, vc, g = _split(h @ w_in[l], IN_SIZES)
        o_a = stick_breaking_attention(heads(qa, H_SB, HEAD_DIM), heads(ka, H_SB, HEAD_DIM),
                                       heads(va, H_SB, HEAD_DIM))
        o_b = dsa_attention(rmsnorm(heads(qb, H_DSA, HEAD_DIM), qn_dsa[l]), rmsnorm(kb, kn_dsa[l]), vb,
                            heads(qi, H_IDX, D_IDX), ki, wi, bias_dsa)
        o_c = sliding_window_attention(rmsnorm(heads(qc, H_SW, HEAD_DIM), qn_swa[l]),
                                       rmsnorm(heads(kc, KV_SW, HEAD_DIM), kn_swa[l]),
                                       heads(vc, KV_SW, HEAD_DIM), sinks[l], bias_swa)
        gates = jax.nn.sigmoid((g.reshape(B_, S_, N_BRANCH, D) + b_gate[l]).astype(jnp.float32)).astype(x.dtype)
        merged = (gates[:, :, 0] * (o_a.reshape(B_, S_, -1) @ w_pa[l])
                  + gates[:, :, 1] * (o_b.reshape(B_, S_, -1) @ w_pb[l])
                  + gates[:, :, 2] * (o_c.reshape(B_, S_, -1) @ w_pc[l]))
        x = x + merged @ w_out[l]
        x = x + cross_attention(rmsnorm(x, norm_x[l]), rmsnorm(mem, norm_mem[l]),
                                w_xq[l], w_xkv[l], w_xo[l], qn_x[l], kn_x[l])
        hf = rmsnorm(x, norm_ffn[l])
        if l % 2 == 0:
            x = x + swiglu(hf, w_gu_dense[l // 2], w_down_dense[l // 2])
        else:
            x = x + moe_swiglu(hf, w_router[l // 2], w_gu_moe[l // 2], w_down_moe[l // 2])
    return x
```

```cpp
#include <hip/hip_runtime.h>
#include <cstdio>
#include <cstdint>

#define LAS __attribute__((address_space(3)))
#define GAS __attribute__((address_space(1)))
typedef unsigned short bf16_t;
typedef short bf16x8 __attribute__((ext_vector_type(8)));
typedef float f32x4 __attribute__((ext_vector_type(4)));
typedef float f32x2 __attribute__((ext_vector_type(2)));
typedef unsigned u32x4 __attribute__((ext_vector_type(4)));
typedef unsigned u32x2 __attribute__((ext_vector_type(2)));

constexpr int D = 1024, BATCH = 16, SEQ = 2048, T = BATCH * SEQ, DEPTH = 2;
constexpr int NIN = 5316, NINP = 5376, NHEADC = 2304, NGATE = 3072;
constexpr int DFF = 2816, NEXP = 8, DFFE = 3584, NMEM = 256, TM = BATCH * NMEM;
constexpr int MAXSLOT = 67584;
constexpr float EPS = 1e-6f;

__device__ __forceinline__ unsigned f2bf(float f) { unsigned u = __builtin_bit_cast(unsigned, f); return (u + 0x7fffu + ((u >> 16) & 1u)) >> 16; }
__device__ __forceinline__ unsigned pk2(float lo, float hi) { return f2bf(lo) | (f2bf(hi) << 16); }
__device__ __forceinline__ float bf2f(unsigned short b) { return __builtin_bit_cast(float, ((unsigned)b) << 16); }
__device__ __forceinline__ float bflo(unsigned w) { return __builtin_bit_cast(float, w << 16); }
__device__ __forceinline__ float bfhi(unsigned w) { return __builtin_bit_cast(float, w & 0xffff0000u); }
typedef __bf16 bf16x2_t __attribute__((ext_vector_type(2)));
__device__ __forceinline__ unsigned cvt_pk_bf16(float lo, float hi) { const f32x2 v = {lo, hi}; const bf16x2_t b = __builtin_convertvector(v, bf16x2_t); return __builtin_bit_cast(unsigned, b); }

__device__ __forceinline__ float shx(float v, int o, int lane) { return __builtin_bit_cast(float, __builtin_amdgcn_ds_bpermute((lane ^ o) << 2, __builtin_bit_cast(int, v))); }
__device__ __forceinline__ int shdi(int v, int o, int lane) { return __builtin_amdgcn_ds_bpermute((lane + o) << 2, v); }

namespace pg8 {
constexpr int BM = 256, BK = 64, HALF = 128, HTB = HALF * BK * 2, STAGE_BYTES = 8 * HTB, NXCD = 8, WGM = 8;
__host__ __device__ __forceinline__ int lds_byte(int r, int c) { const int st = (r >> 4) * 2 + (c >> 5), rr = r & 15, cc = c & 31, ob = rr * 64 + cc * 2; return st * 1024 + (ob ^ (((ob >> 9) & 1) << 5)); }
__host__ __device__ __forceinline__ void stage_rc(int b, int& R, int& C) { const int st = b / 1024, sb = b % 1024, swz = sb ^ (((sb >> 9) & 1) << 5); R = (st >> 1) * 16 + swz / 64; C = (st & 1) * 32 + (swz % 64) / 2; }
__host__ __device__ __forceinline__ int perm32(int rho) { const int n = rho >> 4, i = rho & 15; return 8 * (i >> 2) + 4 * n + (i & 3); }

struct Unit { int pm, pn, g; };

struct TileOrder {
    int nM, nN, nwg;
    __device__ __forceinline__ void init(int nM_, int nN_) { nM = nM_; nN = nN_; nwg = nM * nN; }
    __device__ __forceinline__ bool get(long L, int& pm, int& pn) const {
        if (L >= nwg) return false;
        int wgid = (int)L; { const int q = nwg / NXCD, r = nwg % NXCD, xcd = wgid % NXCD, off = wgid / NXCD; wgid = (xcd < r ? xcd * (q + 1) : r * (q + 1) + (xcd - r) * q) + off; }
        const int nig = WGM * nN, gid = wgid / nig, fm = gid * WGM, gsz = (nM - fm) < WGM ? (nM - fm) : WGM;
        pm = fm + ((wgid % nig) % gsz); pn = (wgid % nig) / gsz; return true;
    }
};

template <class Epi, class Sched>
__device__ __forceinline__ void gemm_phase(LAS unsigned char* lds, const Sched& S, const Epi& E, const int lda, const int ldb) {
    int tid = threadIdx.x; asm volatile("" : "+v"(tid));
    const int wid = __builtin_amdgcn_readfirstlane(tid >> 6), lane = tid & 63, wr = wid >> 2, wc = wid & 3, fr = lane & 15, fq = lane >> 4;
    unsigned voffA[2], voffB[2];
#pragma unroll
    for (int i = 0; i < 2; ++i) { int R, C; stage_rc(tid * 16 + i * 8192, R, C); const int Rb = Epi::PERM ? ((R & ~31) + perm32(R & 31)) : R;
        voffA[i] = (unsigned)(R * lda + C) * 2u; voffB[i] = (unsigned)(Rb * ldb + C) * 2u; }
    const size_t kstep = (size_t)(BK * 2);
    const size_t hstepA = (size_t)HALF * lda * 2, hstepB = (size_t)HALF * ldb * 2;
    const unsigned ldsw = (unsigned)wid * 1024u;
    const int aoff = lds_byte(wr * 64 + fr, fq * 8), boff = lds_byte(wc * 32 + fr, fq * 8);
#define PG8_SA(b, h) (((b) * 2 + (h)) * HTB)
#define PG8_SB(b, h) ((4 + (b) * 2 + (h)) * HTB)
#define PG8_STAGE(bufoff, gbase, voff) do { _Pragma("unroll") for (int _i = 0; _i < 2; ++_i) \
        __builtin_amdgcn_global_load_lds((const unsigned*)((const char*)(gbase) + (voff)[_i]), (LAS unsigned*)(lds + (bufoff) + ldsw + _i * 8192), 16, 0, 0); } while (0)
#define PG8_LDA(dst, b, h) do { _Pragma("unroll") for (int m = 0; m < 4; ++m) _Pragma("unroll") for (int k = 0; k < 2; ++k) dst[m][k] = *(const LAS bf16x8*)(lds + PG8_SA(b, h) + aoff + m * 2048 + k * 1024); } while (0)
#define PG8_LDB(dst, b, h) do { _Pragma("unroll") for (int n = 0; n < 2; ++n) _Pragma("unroll") for (int k = 0; k < 2; ++k) dst[n][k] = *(const LAS bf16x8*)(lds + PG8_SB(b, h) + boff + n * 2048 + k * 1024); } while (0)
#define PG8_MMA(ai, bj, At, Bt) do { __builtin_amdgcn_s_setprio(1); _Pragma("unroll") for (int m = 0; m < 4; ++m) _Pragma("unroll") for (int n = 0; n < 2; ++n) _Pragma("unroll") for (int k = 0; k < 2; ++k) \
        acc[ai][bj][m][n] = __builtin_amdgcn_mfma_f32_16x16x32_bf16(Bt[n][k], At[m][k], acc[ai][bj][m][n], 0, 0, 0); __builtin_amdgcn_s_setprio(0); } while (0)
#define PG8_WAIT_V(n) asm volatile("s_waitcnt vmcnt(" #n ")" ::: "memory")
#define PG8_WAIT_L(n) asm volatile("s_waitcnt lgkmcnt(" #n ")" ::: "memory")
#define PG8_BAR __builtin_amdgcn_s_barrier()
#define PG8_SCHED __builtin_amdgcn_sched_barrier(0)
    Unit cur, nxt; int ui = 0;
    if (!S.next(0, cur)) return;
    f32x4 acc[2][2][4][2];
#pragma unroll
    for (int a = 0; a < 2; ++a)
#pragma unroll
        for (int b = 0; b < 2; ++b)
#pragma unroll
            for (int m = 0; m < 4; ++m)
#pragma unroll
                for (int n = 0; n < 2; ++n) acc[a][b][m][n] = (f32x4){0.f, 0.f, 0.f, 0.f};
    bf16x8 At[4][2], B0[2][2], B1[2][2];
    const char* cA = S.a_ptr(cur); const char* cB = S.b_ptr(cur); int nt = S.nt(cur);
    PG8_STAGE(PG8_SB(0, 0), cB, voffB); PG8_STAGE(PG8_SB(0, 1), cB + hstepB, voffB); PG8_STAGE(PG8_SA(0, 0), cA, voffA); PG8_STAGE(PG8_SA(0, 1), cA + hstepA, voffA);
    if (wr == 1) PG8_BAR;
    PG8_WAIT_V(2); PG8_BAR;
    PG8_STAGE(PG8_SB(1, 0), cB + kstep, voffB); PG8_STAGE(PG8_SA(1, 0), cA + kstep, voffA); PG8_STAGE(PG8_SB(1, 1), cB + hstepB + kstep, voffB);
    PG8_WAIT_V(6); PG8_BAR;
    for (;;) {
        const bool has_next = S.next(ui + 1, nxt);
        const char* nA = cA; const char* nB = cB; int nnt = nt;
        if (has_next) { nA = S.a_ptr(nxt); nB = S.b_ptr(nxt); nnt = S.nt(nxt); }
        for (int t = 0; t < nt; t += 2) {
            if constexpr (Epi::HOOK) { if (t == 4 || t == 8) E.mid(acc, cur, t, wr, wc, fr, fq); }
            const bool last = (t == nt - 2);
            const char* a1 = cA + (size_t)(t + 1) * kstep;
            const char* a2 = last ? nA : cA + (size_t)(t + 2) * kstep; const char* b2 = last ? nB : cB + (size_t)(t + 2) * kstep;
            const char* a3 = a2 + kstep; const char* b3 = b2 + kstep;
            PG8_LDB(B0, 0, 0); PG8_LDB(B1, 0, 1); PG8_SCHED; PG8_LDA(At, 0, 0); PG8_STAGE(PG8_SA(1, 1), a1 + hstepA, voffA);
            PG8_WAIT_V(8); PG8_WAIT_L(0); PG8_BAR; PG8_MMA(0, 0, At, B0); PG8_MMA(0, 1, At, B1); PG8_BAR; PG8_SCHED;
            PG8_LDA(At, 0, 1); PG8_STAGE(PG8_SB(0, 0), b2, voffB); PG8_STAGE(PG8_SB(0, 1), b2 + hstepB, voffB); PG8_STAGE(PG8_SA(0, 0), a2, voffA);
            PG8_WAIT_V(8); PG8_WAIT_L(0); PG8_BAR; PG8_MMA(1, 0, At, B0); PG8_MMA(1, 1, At, B1); PG8_BAR; PG8_SCHED;
            PG8_LDB(B0, 1, 0); PG8_LDB(B1, 1, 1); PG8_SCHED; PG8_LDA(At, 1, 0); PG8_STAGE(PG8_SA(0, 1), a2 + hstepA, voffA);
            PG8_WAIT_V(8); PG8_WAIT_L(0); PG8_BAR; PG8_MMA(0, 0, At, B0); PG8_MMA(0, 1, At, B1); PG8_BAR; PG8_SCHED;
            PG8_LDA(At, 1, 1); PG8_STAGE(PG8_SB(1, 0), b3, voffB); PG8_STAGE(PG8_SB(1, 1), b3 + hstepB, voffB); PG8_STAGE(PG8_SA(1, 0), a3, voffA);
            PG8_WAIT_V(8); PG8_WAIT_L(0); PG8_BAR; PG8_MMA(1, 0, At, B0); PG8_MMA(1, 1, At, B1); PG8_BAR; PG8_SCHED;
        }
        if (wr == 0) PG8_BAR;
        E(acc, cur, wr, wc, fr, fq);
        if (!has_next) break;
#pragma unroll
        for (int a = 0; a < 2; ++a)
#pragma unroll
            for (int b = 0; b < 2; ++b)
#pragma unroll
                for (int m = 0; m < 4; ++m)
#pragma unroll
                    for (int n = 0; n < 2; ++n) acc[a][b][m][n] = (f32x4){0.f, 0.f, 0.f, 0.f};
        cur = nxt; cA = nA; cB = nB; nt = nnt; ++ui;
        if (wr == 1) PG8_BAR;
    }
    PG8_WAIT_V(0);
    PG8_BAR;
#undef PG8_SA
#undef PG8_SB
#undef PG8_STAGE
#undef PG8_LDA
#undef PG8_LDB
#undef PG8_MMA
#undef PG8_WAIT_V
#undef PG8_WAIT_L
#undef PG8_BAR
#undef PG8_SCHED
}
}
namespace pg8 {
__device__ __forceinline__ float sigmoidf_(float x) { return __builtin_amdgcn_rcpf(1.0f + __builtin_amdgcn_exp2f(x * -1.4426950408889634f)); }

struct SchedPlain {
    TileOrder to; int G, c, ntk; const char* A; const char* B; size_t astep, bstep;
    __device__ __forceinline__ void init(const void* A_, const void* B_, int M, int N, int K, int lda, int ldb, int G_, int c_) {
        to.init(M / BM, N / BM); G = G_; c = c_; ntk = K / BK; A = (const char*)A_; B = (const char*)B_; astep = (size_t)BM * lda * 2; bstep = (size_t)BM * ldb * 2; }
    __device__ __forceinline__ bool next(int i, Unit& u) const { u.g = 0; return to.get((long)i * G + c, u.pm, u.pn); }
    __device__ __forceinline__ const char* a_ptr(const Unit& u) const { return A + (size_t)u.pm * astep; }
    __device__ __forceinline__ const char* b_ptr(const Unit& u) const { return B + (size_t)u.pn * bstep; }
    __device__ __forceinline__ int nt(const Unit&) const { return ntk; }
};
struct SchedG1 {
    TileOrder th, tg; int G, c; const char* A; const char* B;
    __device__ __forceinline__ void init(const void* A_, const void* B_, int G_, int c_) { th.init(T / BM, 9); tg.init(T / BM, 12); G = G_; c = c_; A = (const char*)A_; B = (const char*)B_; }
    __device__ __forceinline__ bool next(int i, Unit& u) const { const long L = (long)i * G + c; u.g = 0;
        if (L < th.nwg) return th.get(L, u.pm, u.pn);
        if (!tg.get(L - th.nwg, u.pm, u.pn)) return false; u.pn += 9; return true; }
    __device__ __forceinline__ const char* a_ptr(const Unit& u) const { return A + (size_t)u.pm * BM * D * 2; }
    __device__ __forceinline__ const char* b_ptr(const Unit& u) const { return B + (size_t)u.pn * BM * D * 2; }
    __device__ __forceinline__ int nt(const Unit&) const { return D / BK; }
};
struct SchedMerge {
    TileOrder to; int G, c; const char* A; const char* B;
    __device__ __forceinline__ void init(const void* A_, const void* B_, int G_, int c_) { to.init(T / BM, D / BM); G = G_; c = c_; A = (const char*)A_; B = (const char*)B_; }
    __device__ __forceinline__ bool next(int i, Unit& u) const { const int ti = i / 3; u.g = i - 3 * ti; return to.get((long)ti * G + c, u.pm, u.pn); }
    __device__ __forceinline__ int koff(int g) const { return g == 0 ? 0 : (g == 1 ? 256 : 512); }
    __device__ __forceinline__ const char* a_ptr(const Unit& u) const { return A + ((size_t)u.pm * BM * D + koff(u.g)) * 2; }
    __device__ __forceinline__ const char* b_ptr(const Unit& u) const { return B + ((size_t)u.pn * BM * D + koff(u.g)) * 2; }
    __device__ __forceinline__ int nt(const Unit& u) const { return u.g == 2 ? 8 : 4; }
};
struct SchedMemKV {
    int G, c; const char* A; const char* B0; const char* B1;
    __device__ __forceinline__ bool next(int i, Unit& u) const { const long L = (long)i * G + c; if (L >= 128) return false; u.pm = (int)L >> 2; u.pn = (int)L & 3; u.g = u.pm >> 4; return true; }
    __device__ __forceinline__ const char* a_ptr(const Unit& u) const { return A + (size_t)u.pm * BM * D * 2; }
    __device__ __forceinline__ const char* b_ptr(const Unit& u) const { return (u.g ? B1 : B0) + (size_t)u.pn * BM * D * 2; }
    __device__ __forceinline__ int nt(const Unit&) const { return D / BK; }
};
struct SchedMoe {
    TileOrder to; int G, c, ntk; const char* A; const char* B; size_t astep, bstep, estep; int pb[NEXP + 1];
    __device__ __forceinline__ void init(const void* A_, const void* B_, const int* pbase, int N, int K, int G_, int c_) {
#pragma unroll
        for (int e = 0; e <= NEXP; ++e) pb[e] = pbase[e];
        to.init(pb[NEXP], N / BM); G = G_; c = c_; ntk = K / BK; A = (const char*)A_; B = (const char*)B_; astep = (size_t)BM * K * 2; bstep = (size_t)BM * K * 2; estep = (size_t)N * K * 2; }
    __device__ __forceinline__ bool next(int i, Unit& u) const { if (!to.get((long)i * G + c, u.pm, u.pn)) return false; int e = 0;
#pragma unroll
        for (int j = 1; j < NEXP; ++j) e += (u.pm >= pb[j]) ? 1 : 0;
        u.g = e; return true; }
    __device__ __forceinline__ const char* a_ptr(const Unit& u) const { return A + (size_t)u.pm * astep; }
    __device__ __forceinline__ const char* b_ptr(const Unit& u) const { return B + (size_t)u.g * estep + (size_t)u.pn * bstep; }
    __device__ __forceinline__ int nt(const Unit&) const { return ntk; }
};

struct EpiResid {
    static constexpr bool PERM = false, HOOK = false;
    const float* base; float* out; int ldc;
    __device__ __forceinline__ void operator()(const f32x4 (&acc)[2][2][4][2], const Unit& u, int wr, int wc, int fr, int fq) const {
        const int row0 = u.pm * BM + wr * 64 + fr, col0 = u.pn * BM + wc * 32 + 4 * fq;
#pragma unroll
        for (int ai = 0; ai < 2; ++ai)
#pragma unroll
            for (int m = 0; m < 4; ++m) { const size_t off = (size_t)(row0 + ai * HALF + m * 16) * ldc + col0;
                f32x4 bs[2][2];
#pragma unroll
                for (int bj = 0; bj < 2; ++bj)
#pragma unroll
                    for (int n = 0; n < 2; ++n) bs[bj][n] = *(const f32x4*)(base + off + bj * HALF + n * 16);
#pragma unroll
                for (int bj = 0; bj < 2; ++bj)
#pragma unroll
                    for (int n = 0; n < 2; ++n) *(f32x4*)(out + off + bj * HALF + n * 16) = bs[bj][n] + acc[ai][bj][m][n];
                asm volatile("" ::: "memory"); }
    }
};
struct EpiResidB {
    static constexpr bool PERM = true, HOOK = false;
    const void* base; int ldb; int base_f32; bf16_t* out; int ldc;
    __device__ __forceinline__ void operator()(const f32x4 (&acc)[2][2][4][2], const Unit& u, int wr, int wc, int fr, int fq) const {
        const int row0 = u.pm * BM + wr * 64 + fr, col0 = u.pn * BM + wc * 32 + 8 * fq;
#pragma unroll
        for (int ai = 0; ai < 2; ++ai)
#pragma unroll
            for (int m = 0; m < 4; ++m) { const int row = row0 + ai * HALF + m * 16;
                f32x4 bs[2][2];
                if (base_f32) {
#pragma unroll
                    for (int bj = 0; bj < 2; ++bj) { const float* bp = (const float*)base + (size_t)row * ldb + col0 + bj * HALF; bs[bj][0] = *(const f32x4*)bp; bs[bj][1] = *(const f32x4*)(bp + 4); }
                } else {
#pragma unroll
                    for (int bj = 0; bj < 2; ++bj) { const u32x4 w = *(const u32x4*)((const bf16_t*)base + (size_t)row * ldb + col0 + bj * HALF);
                        bs[bj][0] = f32x4{bflo(w.x), bfhi(w.x), bflo(w.y), bfhi(w.y)}; bs[bj][1] = f32x4{bflo(w.z), bfhi(w.z), bflo(w.w), bfhi(w.w)}; }
                }
                bf16_t* rowp = out + (size_t)row * ldc + col0;
#pragma unroll
                for (int bj = 0; bj < 2; ++bj) { const f32x4 v0 = acc[ai][bj][m][0] + bs[bj][0], v1 = acc[ai][bj][m][1] + bs[bj][1];
                    u32x4 w; w.x = cvt_pk_bf16(v0[0], v0[1]); w.y = cvt_pk_bf16(v0[2], v0[3]); w.z = cvt_pk_bf16(v1[0], v1[1]); w.w = cvt_pk_bf16(v1[2], v1[3]);
                    *(u32x4*)(rowp + bj * HALF) = w; }
                asm volatile("" ::: "memory"); }
    }
};
struct EpiBf16 {
    static constexpr bool PERM = true, HOOK = false;
    bf16_t* O; int ldc;
    __device__ __forceinline__ void operator()(const f32x4 (&acc)[2][2][4][2], const Unit& u, int wr, int wc, int fr, int fq) const {
        const int row0 = u.pm * BM + wr * 64 + fr, col0 = u.pn * BM + wc * 32 + 8 * fq;
#pragma unroll
        for (int ai = 0; ai < 2; ++ai)
#pragma unroll
            for (int m = 0; m < 4; ++m) { bf16_t* rowp = O + (size_t)(row0 + ai * HALF + m * 16) * ldc + col0;
#pragma unroll
                for (int bj = 0; bj < 2; ++bj) { const f32x4 v0 = acc[ai][bj][m][0], v1 = acc[ai][bj][m][1];
                    u32x4 w; w.x = cvt_pk_bf16(v0[0], v0[1]); w.y = cvt_pk_bf16(v0[2], v0[3]); w.z = cvt_pk_bf16(v1[0], v1[1]); w.w = cvt_pk_bf16(v1[2], v1[3]);
                    *(u32x4*)(rowp + bj * HALF) = w; } }
    }
};
struct EpiG1 {
    static constexpr bool PERM = true, HOOK = false;
    bf16_t* qkv;
    bf16_t* gates;
    const float* bgate;
    const float *gn_qb, *gn_kb, *gn_qc, *gn_kc;
    __device__ __forceinline__ void operator()(const f32x4 (&acc)[2][2][4][2], const Unit& u, int wr, int wc, int fr, int fq) const {
        const int row0 = u.pm * BM + wr * 64 + fr;
        if (u.pn < 9) {
            const int slot = 4 * u.pn + wc;
            if (slot == 35) return;
            size_t dst; int pitch, head; const float* gn = nullptr;
            if (slot < 4)       { dst = 0;                        pitch = 256; head = slot; }
            else if (slot < 8)  { dst = (size_t)T * 256;          pitch = 256; head = slot - 4; }
            else if (slot < 12) { dst = (size_t)T * 512;          pitch = 256; head = slot - 8; }
            else if (slot < 16) { dst = (size_t)T * 768;          pitch = 256; head = slot - 12; gn = gn_qb; }
            else if (slot == 16){ dst = (size_t)T * 1024;         pitch = 64;  head = 0; gn = gn_kb; }
            else if (slot == 17){ dst = (size_t)T * 1088;         pitch = 64;  head = 0; }
            else if (slot < 22) { dst = (size_t)T * 1152;         pitch = 256; head = slot - 18; }
            else if (slot == 22){ dst = (size_t)T * 1408;         pitch = 64;  head = 0; }
            else if (slot < 31) { dst = (size_t)T * 1472;         pitch = 512; head = slot - 23; gn = gn_qc; }
            else if (slot < 33) { dst = (size_t)T * 1984;         pitch = 128; head = slot - 31; gn = gn_kc; }
            else                { dst = (size_t)T * 2112;         pitch = 128; head = slot - 33; }
            bf16_t* base = qkv + dst + head * 64 + 8 * fq;
            f32x4 g0[2], g1[2];
            if (gn) {
#pragma unroll
                for (int bj = 0; bj < 2; ++bj) { g0[bj] = *(const f32x4*)(gn + 32 * bj + 8 * fq); g1[bj] = *(const f32x4*)(gn + 32 * bj + 8 * fq + 4); }
            }
#pragma unroll
            for (int ai = 0; ai < 2; ++ai)
#pragma unroll
                for (int m = 0; m < 4; ++m) {
                    f32x4 v[2][2];
#pragma unroll
                    for (int bj = 0; bj < 2; ++bj) { v[bj][0] = acc[ai][bj][m][0]; v[bj][1] = acc[ai][bj][m][1]; }
                    if (gn) {
                        float ss = 0.f;
#pragma unroll
                        for (int bj = 0; bj < 2; ++bj)
#pragma unroll
                            for (int n = 0; n < 2; ++n) ss += (v[bj][n][0] * v[bj][n][0] + v[bj][n][1] * v[bj][n][1]) + (v[bj][n][2] * v[bj][n][2] + v[bj][n][3] * v[bj][n][3]);
                        ss += shx(ss, 16, 16 * fq + fr); ss += shx(ss, 32, 16 * fq + fr);
                        const float r = __builtin_amdgcn_rsqf(ss * (1.0f / 64.0f) + EPS);
#pragma unroll
                        for (int bj = 0; bj < 2; ++bj) { v[bj][0] = v[bj][0] * r * g0[bj]; v[bj][1] = v[bj][1] * r * g1[bj]; }
                    }
                    bf16_t* rowp = base + (size_t)(row0 + ai * HALF + m * 16) * pitch;
#pragma unroll
                    for (int bj = 0; bj < 2; ++bj) { u32x4 w; w.x = cvt_pk_bf16(v[bj][0][0], v[bj][0][1]); w.y = cvt_pk_bf16(v[bj][0][2], v[bj][0][3]); w.z = cvt_pk_bf16(v[bj][1][0], v[bj][1][1]); w.w = cvt_pk_bf16(v[bj][1][2], v[bj][1][3]);
                        *(u32x4*)(rowp + 32 * bj) = w; }
                }
        } else {
            const int col0 = (u.pn - 9) * BM + wc * 32 + 8 * fq;
            f32x4 bv[2][2];
#pragma unroll
            for (int bj = 0; bj < 2; ++bj)
#pragma unroll
                for (int n = 0; n < 2; ++n) bv[bj][n] = *(const f32x4*)(bgate + col0 + bj * HALF + 4 * n);
#pragma unroll
            for (int ai = 0; ai < 2; ++ai)
#pragma unroll
                for (int m = 0; m < 4; ++m) { bf16_t* rowp = gates + (size_t)(row0 + ai * HALF + m * 16) * NGATE + col0;
#pragma unroll
                    for (int bj = 0; bj < 2; ++bj) { f32x4 v0 = acc[ai][bj][m][0] + bv[bj][0], v1 = acc[ai][bj][m][1] + bv[bj][1];
#pragma unroll
                        for (int j = 0; j < 4; ++j) { v0[j] = sigmoidf_(v0[j]); v1[j] = sigmoidf_(v1[j]); }
                        u32x4 w; w.x = cvt_pk_bf16(v0[0], v0[1]); w.y = cvt_pk_bf16(v0[2], v0[3]); w.z = cvt_pk_bf16(v1[0], v1[1]); w.w = cvt_pk_bf16(v1[2], v1[3]);
                        *(u32x4*)(rowp + bj * HALF) = w; } }
        }
    }
};
struct EpiMerge {
    static constexpr bool PERM = true, HOOK = true;
    const bf16_t* gates; bf16_t* mb;
    __device__ __forceinline__ void mid(f32x4 (&acc)[2][2][4][2], const Unit& u, int t, int wr, int wc, int fr, int fq) const {
        int row0 = u.pm * BM + wr * 64 + fr; const int col0 = u.pn * BM + wc * 32 + 8 * fq, ga = (t == 4) ? 0 : D, gb = ga + D;
        asm volatile("" : "+v"(row0));
#pragma unroll
        for (int ai = 0; ai < 2; ++ai)
#pragma unroll
            for (int m = 0; m < 4; ++m) { const bf16_t* gp = gates + (size_t)(row0 + ai * HALF + m * 16) * NGATE + col0;
#pragma unroll
                for (int bj = 0; bj < 2; ++bj) { const u32x4 na = *(const u32x4*)(gp + ga + bj * HALF), nb = *(const u32x4*)(gp + gb + bj * HALF);
                    const float a[8] = {bflo(na.x), bfhi(na.x), bflo(na.y), bfhi(na.y), bflo(na.z), bfhi(na.z), bflo(na.w), bfhi(na.w)};
                    const float b[8] = {bflo(nb.x), bfhi(nb.x), bflo(nb.y), bfhi(nb.y), bflo(nb.z), bfhi(nb.z), bflo(nb.w), bfhi(nb.w)};
#pragma unroll
                    for (int j = 0; j < 4; ++j) { acc[ai][bj][m][0][j] *= fmaxf(a[j], 1e-12f) * __builtin_amdgcn_rcpf(fmaxf(b[j], 1e-12f));
                        acc[ai][bj][m][1][j] *= fmaxf(a[4 + j], 1e-12f) * __builtin_amdgcn_rcpf(fmaxf(b[4 + j], 1e-12f)); } }
                if (m & 1) asm volatile("" ::: "memory"); }
    }
    __device__ __forceinline__ void operator()(const f32x4 (&acc)[2][2][4][2], const Unit& u, int wr, int wc, int fr, int fq) const {
        const int row0 = u.pm * BM + wr * 64 + fr, col0 = u.pn * BM + wc * 32 + 8 * fq;
#pragma unroll
        for (int ai = 0; ai < 2; ++ai)
#pragma unroll
            for (int m = 0; m < 4; ++m) { const size_t row = (size_t)(row0 + ai * HALF + m * 16);
#pragma unroll
                for (int bj = 0; bj < 2; ++bj) { const int col = col0 + bj * HALF;
                    const u32x4 gw = *(const u32x4*)(gates + row * NGATE + 2 * D + col);
                    f32x4 v0 = acc[ai][bj][m][0], v1 = acc[ai][bj][m][1];
                    v0[0] *= fmaxf(bflo(gw.x), 1e-12f); v0[1] *= fmaxf(bfhi(gw.x), 1e-12f); v0[2] *= fmaxf(bflo(gw.y), 1e-12f); v0[3] *= fmaxf(bfhi(gw.y), 1e-12f);
                    v1[0] *= fmaxf(bflo(gw.z), 1e-12f); v1[1] *= fmaxf(bfhi(gw.z), 1e-12f); v1[2] *= fmaxf(bflo(gw.w), 1e-12f); v1[3] *= fmaxf(bfhi(gw.w), 1e-12f);
                    u32x4 w; w.x = cvt_pk_bf16(v0[0], v0[1]); w.y = cvt_pk_bf16(v0[2], v0[3]); w.z = cvt_pk_bf16(v1[0], v1[1]); w.w = cvt_pk_bf16(v1[2], v1[3]);
                    *(u32x4*)(mb + row * D + col) = w; } }
    }
};
struct EpiSwiglu {
    static constexpr bool PERM = true, HOOK = false;
    bf16_t* O; int ldc;
    __device__ __forceinline__ void operator()(const f32x4 (&acc)[2][2][4][2], const Unit& u, int wr, int wc, int fr, int fq) const {
        const int row0 = u.pm * BM + wr * 64 + fr, col0 = u.pn * HALF + wc * 32 + 8 * fq;
#pragma unroll
        for (int ai = 0; ai < 2; ++ai)
#pragma unroll
            for (int m = 0; m < 4; ++m) { bf16_t* rowp = O + (size_t)(row0 + ai * HALF + m * 16) * ldc + col0;
                f32x4 r[2];
#pragma unroll
                for (int n = 0; n < 2; ++n) { const f32x4 g = acc[ai][0][m][n], uu = acc[ai][1][m][n];
#pragma unroll
                    for (int j = 0; j < 4; ++j) r[n][j] = g[j] * sigmoidf_(g[j]) * uu[j]; }
                u32x4 w; w.x = cvt_pk_bf16(r[0][0], r[0][1]); w.y = cvt_pk_bf16(r[0][2], r[0][3]); w.z = cvt_pk_bf16(r[1][0], r[1][1]); w.w = cvt_pk_bf16(r[1][2], r[1][3]);
                *(u32x4*)rowp = w; }
    }
};
struct EpiMoeDown {
    static constexpr bool PERM = true, HOOK = false;
    bf16_t* Y; const float* sgate;
    __device__ __forceinline__ void operator()(const f32x4 (&acc)[2][2][4][2], const Unit& u, int wr, int wc, int fr, int fq) const {
        const int row0 = u.pm * BM + wr * 64 + fr, col0 = u.pn * BM + wc * 32 + 8 * fq;
#pragma unroll
        for (int ai = 0; ai < 2; ++ai)
#pragma unroll
            for (int m = 0; m < 4; ++m) { const int row = row0 + ai * HALF + m * 16; const float gt = sgate[row]; bf16_t* rowp = Y + (size_t)row * D + col0;
#pragma unroll
                for (int bj = 0; bj < 2; ++bj) { const f32x4 v0 = acc[ai][bj][m][0] * gt, v1 = acc[ai][bj][m][1] * gt;
                    u32x4 w; w.x = cvt_pk_bf16(v0[0], v0[1]); w.y = cvt_pk_bf16(v0[2], v0[3]); w.z = cvt_pk_bf16(v1[0], v1[1]); w.w = cvt_pk_bf16(v1[2], v1[3]);
                    *(u32x4*)(rowp + bj * HALF) = w; } }
    }
};
}
constexpr size_t MiB = 1u << 20;
constexpr size_t WS_CTL = 0, CTL_ZERO_BYTES = 1 * MiB;
constexpr size_t WS_SMALL = 1 * MiB;
constexpr size_t WS_WI    = WS_SMALL;
constexpr size_t WS_TOKE  = WS_SMALL + 512 * 1024;
constexpr size_t WS_TOKG  = WS_TOKE + 256 * 1024;
constexpr size_t WS_TOKS  = WS_TOKG + 256 * 1024;
constexpr size_t WS_STOK  = WS_TOKS + 256 * 1024;
constexpr size_t WS_SGATE = WS_STOK + 272 * 1024;
constexpr size_t WS_CNT   = WS_SGATE + 272 * 1024;
constexpr size_t WS_PBASE = WS_CNT + 8192;
static_assert(WS_PBASE + 64 <= 4 * MiB, "small arrays");
constexpr size_t WS_W = 4 * MiB;
constexpr size_t WO_IN   = 0;
constexpr size_t WO_P    = WO_IN + 2ull * NINP * D;
constexpr size_t WO_OUT  = WO_P + 2ull * D * D;
constexpr size_t WO_XQ   = WO_OUT + 2ull * D * D;
constexpr size_t WO_XKV  = WO_XQ + 2ull * 512 * D;
constexpr size_t WO_XO   = WO_XKV + 2ull * D * D;
constexpr size_t WO_GUD  = WO_XO + 2ull * D * 512;
constexpr size_t WO_DND  = WO_GUD + 2ull * DFF * D;
constexpr size_t WO_GUM  = WO_DND + (size_t)D * DFF;
constexpr size_t WO_DNM  = WO_GUM + 8ull * 2 * DFFE * D;
constexpr size_t WO_END  = WO_DNM + 8ull * D * DFFE;
static_assert(WO_END * 2 <= 224 * MiB, "weights fit");
constexpr size_t WS_XN   = 228 * MiB;
constexpr size_t WS_R    = 292 * MiB;
constexpr size_t WS_QKV  = WS_R;
constexpr size_t WS_GATES= WS_R + 144 * MiB;
constexpr size_t WS_O    = WS_R + 336 * MiB;
constexpr size_t WS_MB   = WS_R + 400 * MiB;
constexpr size_t WS_MEMN = WS_R + 464 * MiB;
constexpr size_t WS_MEMKV= WS_R + 480 * MiB;
constexpr size_t WS_MF   = WS_R;
constexpr size_t WS_QX   = WS_R;
constexpr size_t WS_OX   = WS_R + 32 * MiB;
constexpr size_t WS_ACTD = WS_R;
constexpr size_t WS_AG   = WS_R;
constexpr size_t WS_Y    = WS_R;
constexpr size_t WS_ACTM = WS_R + 132 * MiB;
constexpr size_t WS_END  = WS_ACTM + 462 * MiB;
static_assert((size_t)MAXSLOT * DFFE * 2 <= 462 * MiB && (size_t)MAXSLOT * D * 2 <= 132 * MiB, "moe buffers");

constexpr int CW_BAR = 4096;

constexpr int RING_BYTES = 131072;
constexpr int LDS_BYTES = 163840;
constexpr int LDSCTL_OFF = LDS_BYTES - 1024, MISC_OFF = LDSCTL_OFF + 320;
constexpr int NWAVES = 8, NTHR = 512;

typedef GAS unsigned gu32;
#define RLX_AGENT __ATOMIC_RELAXED, __HIP_MEMORY_SCOPE_AGENT
#define LDS_WAIT() asm volatile("s_waitcnt lgkmcnt(0)" ::: "memory")
#define VM_WAIT() asm volatile("s_waitcnt vmcnt(0)" ::: "memory")

#define XB_TMO      128
#define XB_XCNT(j)  (256  + 64 * (j))
#define XB_XSUB(j)  (1280 + 64 * (j))
#define XB_XGEN(j)  (2304 + 64 * (j))
#define XB_TOP      3328
#define XB_TOPGEN   3392
#define XCD_BAR_WORDS 3456
#define XB_SPIN_CAP (1u << 22)

__device__ __forceinline__ unsigned xb_ld(unsigned* p)              { return __hip_atomic_load(p, __ATOMIC_RELAXED, __HIP_MEMORY_SCOPE_AGENT); }
__device__ __forceinline__ unsigned xb_add(unsigned* p, unsigned v) { return __hip_atomic_fetch_add(p, v, __ATOMIC_RELAXED, __HIP_MEMORY_SCOPE_AGENT); }
__device__ __forceinline__ unsigned xb_xcc_id() { return (unsigned)__builtin_amdgcn_s_getreg((3 << 11) | 20) & 0xFu; }
#define XB_SPIN(cond, bar) do { unsigned _sp = 0; while (cond) { __builtin_amdgcn_s_sleep(1); \
    if ((++_sp & 255u) == 0u) { if (xb_ld(&(bar)[XB_TMO])) break; if (_sp > XB_SPIN_CAP) { atomicAdd(&(bar)[XB_TMO], 1u); break; } } } } while (0)

struct XcdBarrier { unsigned* bar; unsigned x; volatile LAS unsigned* st; };

__device__ __forceinline__ XcdBarrier xcd_barrier_post(unsigned* bar, volatile LAS unsigned* st) {
    XcdBarrier b; b.bar = bar; b.x = xb_xcc_id(); b.st = st;
    if (threadIdx.x == 0) (void)xb_add(&bar[XB_XCNT(b.x)], 1u);
    return b;
}
__device__ __forceinline__ void xcd_barrier_complete(unsigned* bar, unsigned x, unsigned& nloc, unsigned& nx) {
    const unsigned G = gridDim.x * gridDim.y * gridDim.z;
    unsigned sum, cnt, mine, sp = 0u;
    for (;;) {
        sum = 0u; cnt = 0u; mine = 0u;
#pragma unroll
        for (unsigned j = 0; j < 16; ++j) { const unsigned c = xb_ld(&bar[XB_XCNT(j)]); sum += c; cnt += (c > 0u) ? 1u : 0u; mine = (j == x) ? c : mine; }
        if (sum == G) break;
        __builtin_amdgcn_s_sleep(1);
        if ((++sp & 255u) == 0u) { if (xb_ld(&bar[XB_TMO])) break; if (sp > XB_SPIN_CAP) { atomicAdd(&bar[XB_TMO], 1u); break; } }
    }
    nloc = mine > 0u ? mine : 1u; nx = cnt > 0u ? cnt : 1u;
}
__device__ __forceinline__ void xcd_barrier_impl(unsigned* bar0, unsigned x, volatile LAS unsigned* st) {
    asm volatile("" : "+s"(bar0), "+s"(x));
    XcdBarrier b; b.bar = bar0; b.x = x; b.st = st;
    asm volatile("s_waitcnt vmcnt(0)" ::: "memory");
    __syncthreads();
    if (threadIdx.x == 0) {
        unsigned* bar = b.bar;
        __builtin_amdgcn_s_waitcnt(0);
        unsigned nloc = b.st[0], nx = b.st[1];
        if (nloc == 0u) { xcd_barrier_complete(bar, b.x, nloc, nx); b.st[0] = nloc; b.st[1] = nx; }
        const unsigned old = xb_add(&bar[XB_XSUB(b.x)], 1u);
        const unsigned gen = old / nloc;
        if (old + 1u == (gen + 1u) * nloc) {
            __builtin_amdgcn_fence(__ATOMIC_RELEASE, "agent");
            asm volatile("s_waitcnt vmcnt(0)" ::: "memory");
            const unsigned og = xb_add(&bar[XB_TOP], 1u);
            const unsigned tg = og / nx;
            if (og + 1u == (tg + 1u) * nx) xb_add(&bar[XB_TOPGEN], 1u);
            else XB_SPIN(xb_ld(&bar[XB_TOPGEN]) == tg, bar);
            __builtin_amdgcn_fence(__ATOMIC_ACQUIRE, "agent");
            xb_add(&bar[XB_XGEN(b.x)], 1u);
            asm volatile("s_waitcnt vmcnt(0)" ::: "memory");
        } else {
            XB_SPIN(xb_ld(&bar[XB_XGEN(b.x)]) == gen, bar);
            __builtin_amdgcn_fence(__ATOMIC_ACQUIRE, "agent");
            asm volatile("s_waitcnt vmcnt(0)" ::: "memory");
        }
    }
    __syncthreads();
}
__device__ __forceinline__ void xcd_barrier(const XcdBarrier& b) { xcd_barrier_impl(b.bar, b.x, b.st); }

__device__ __forceinline__ float wave_sum(float v, int lane) {
#pragma unroll
    for (int o = 1; o < 64; o <<= 1) v += shx(v, o, lane);
    return v;
}
__device__ __forceinline__ float wave_max(float v, int lane) {
#pragma unroll
    for (int o = 1; o < 64; o <<= 1) v = fmaxf(v, shx(v, o, lane));
    return v;
}
__device__ __forceinline__ int t5_bucket(int rel) {
    const int n = rel < 0 ? 0 : rel;
    if (n < 16) return n;
    const int large = 16 + (int)(logf((float)n / 16.0f) / 2.0794415416798357f * 16.0f);
    return large < 31 ? large : 31;
}

struct CvtJob { const float* W; int K, Nsrc, Ndst, ldd, kd0, map, dff; bf16_t* WT; };
__device__ __forceinline__ int cvt_srccol(const CvtJob& J, int n0) {
    if (J.map == 0) return n0;
    if (J.map == 1) {
        if (n0 >= NHEADC) return 2244 + (n0 - NHEADC);
        const int pn = n0 >> 8, p = n0 & 255, bj = p >> 7, wc = (p & 127) >> 5, slot = 4 * pn + wc;
        if (slot == 35) return -1;
        return (slot < 23 ? 64 * slot : 1476 + 64 * (slot - 23)) + 32 * bj;
    }
    const int pn = n0 >> 8, p = n0 & 255, bj = p >> 7, w = p & 127;
    return bj * J.dff + 128 * pn + w;
}
__device__ __forceinline__ void cvt_item(const CvtJob& J, LAS float* scr, int item, int lane) {
    const int nblk = J.Ndst / 32, kb = item / nblk, nb = item % nblk, k0 = 64 * kb, n0 = 32 * nb;
    const int sc = cvt_srccol(J, n0);
    if (sc >= 0) {
#pragma unroll
        for (int i = 0; i < 32; ++i) { const int kk = 2 * i + (lane >> 5); scr[kk * 33 + (lane & 31)] = J.W[(size_t)(k0 + kk) * J.Nsrc + sc + (lane & 31)]; }
    } else {
#pragma unroll 8
        for (int i = 0; i < 32; ++i) { const int kk = 2 * i + (lane >> 5); scr[kk * 33 + (lane & 31)] = 0.f; }
    }
    LDS_WAIT(); asm volatile("" ::: "memory");
    const int c = lane & 7;
#pragma unroll
    for (int j = 0; j < 4; ++j) { const int n = (lane >> 3) + 8 * j; const LAS float* s = scr + (8 * c) * 33 + n;
        u32x4 o; o.x = pk2(s[0 * 33], s[1 * 33]); o.y = pk2(s[2 * 33], s[3 * 33]); o.z = pk2(s[4 * 33], s[5 * 33]); o.w = pk2(s[6 * 33], s[7 * 33]);
        *(GAS u32x4*)(J.WT + (size_t)(n0 + n) * J.ldd + J.kd0 + k0 + 8 * c) = o; }
    LDS_WAIT(); asm volatile("" ::: "memory");
}
template <bool XB> __device__ __forceinline__ f32x4 ldx4(const void* x, size_t off) {
    if (XB) { const u32x2 w = *(const u32x2*)((const bf16_t*)x + off); return f32x4{bflo(w.x), bfhi(w.x), bflo(w.y), bfhi(w.y)}; }
    return *(const f32x4*)((const float*)x + off);
}
template <int NP, bool XB>
__device__ __forceinline__ void norm_rows(const void* x, int ldx, const float* gain, bf16_t* xn, int nrows, const float* Wp, int ldwp, float* proj, int gw, int ngw, int lane) {
    f32x4 g[4];
#pragma unroll
    for (int j = 0; j < 4; ++j) g[j] = *(const f32x4*)(gain + 4 * lane + 256 * j);
    float wp[NP > 0 ? NP : 1][16];
    if (NP > 0) {
#pragma unroll
        for (int j = 0; j < 4; ++j)
#pragma unroll
            for (int i = 0; i < 4; ++i)
#pragma unroll
                for (int c = 0; c < NP; ++c) wp[c][4 * j + i] = Wp[(size_t)(4 * lane + 256 * j + i) * ldwp + c];
    }
    for (int m = gw; m < nrows; m += ngw) {
        f32x4 v[4]; float s = 0.f;
#pragma unroll
        for (int j = 0; j < 4; ++j) { v[j] = ldx4<XB>(x, (size_t)m * ldx + 4 * lane + 256 * j); s += (v[j].x * v[j].x + v[j].y * v[j].y) + (v[j].z * v[j].z + v[j].w * v[j].w); }
        const float r = 1.0f / sqrtf(wave_sum(s, lane) * (1.0f / D) + EPS);
#pragma unroll
        for (int j = 0; j < 4; ++j) v[j] = v[j] * r * g[j];
        unsigned long long* o8 = (unsigned long long*)(xn + (size_t)m * D) + lane;
#pragma unroll
        for (int j = 0; j < 4; ++j) o8[64 * j] = (unsigned long long)pk2(v[j].x, v[j].y) | ((unsigned long long)pk2(v[j].z, v[j].w) << 32);
        if (NP > 0) {
#pragma unroll
            for (int c = 0; c < NP; ++c) { float a = 0.f;
#pragma unroll
                for (int j = 0; j < 4; ++j) a += (v[j].x * wp[c][4 * j] + v[j].y * wp[c][4 * j + 1]) + (v[j].z * wp[c][4 * j + 2] + v[j].w * wp[c][4 * j + 3]);
                a = wave_sum(a, lane);
                if (lane == 0) proj[(size_t)m * NP + c] = a; }
        }
    }
}
__device__ __forceinline__ void norm_router(const bf16_t* x, int ldx, const float* gain, bf16_t* xn, const float* Wr  , int* tok_e, float* tok_g, int* cnt  , LAS int* lcnt, int vb, int G, int wave, int lane) {
    f32x4 g[4];
#pragma unroll
    for (int j = 0; j < 4; ++j) g[j] = *(const f32x4*)(gain + 4 * lane + 256 * j);
    float wp[NEXP][16];
#pragma unroll
    for (int j = 0; j < 4; ++j)
#pragma unroll
        for (int i = 0; i < 4; ++i) { const f32x4 a = *(const f32x4*)(Wr + (size_t)(4 * lane + 256 * j + i) * NEXP), b = *(const f32x4*)(Wr + (size_t)(4 * lane + 256 * j + i) * NEXP + 4);
            wp[0][4 * j + i] = a.x; wp[1][4 * j + i] = a.y; wp[2][4 * j + i] = a.z; wp[3][4 * j + i] = a.w; wp[4][4 * j + i] = b.x; wp[5][4 * j + i] = b.y; wp[6][4 * j + i] = b.z; wp[7][4 * j + i] = b.w; }
    for (int c = vb; c < T / 128; c += G) {
        __syncthreads();
        if (threadIdx.x < NEXP) lcnt[threadIdx.x] = 0;
        __syncthreads();
        for (int rr = 0; rr < 16; ++rr) {
            const int m = c * 128 + wave * 16 + rr;
            f32x4 v[4]; float s = 0.f;
#pragma unroll
            for (int j = 0; j < 4; ++j) { v[j] = ldx4<true>(x, (size_t)m * ldx + 4 * lane + 256 * j); s += (v[j].x * v[j].x + v[j].y * v[j].y) + (v[j].z * v[j].z + v[j].w * v[j].w); }
            const float r = 1.0f / sqrtf(wave_sum(s, lane) * (1.0f / D) + EPS);
#pragma unroll
            for (int j = 0; j < 4; ++j) v[j] = v[j] * r * g[j];
            unsigned long long* o8 = (unsigned long long*)(xn + (size_t)m * D) + lane;
#pragma unroll
            for (int j = 0; j < 4; ++j) o8[64 * j] = (unsigned long long)pk2(v[j].x, v[j].y) | ((unsigned long long)pk2(v[j].z, v[j].w) << 32);
            float a8[NEXP];
#pragma unroll
            for (int e = 0; e < NEXP; ++e) { float a = 0.f;
#pragma unroll
                for (int j = 0; j < 4; ++j) a += (v[j].x * wp[e][4 * j] + v[j].y * wp[e][4 * j + 1]) + (v[j].z * wp[e][4 * j + 2] + v[j].w * wp[e][4 * j + 3]);
                a8[e] = a; }
            float b4[4], b2[2], b1;
            { const bool up = (lane & 32) != 0;
#pragma unroll
              for (int i = 0; i < 4; ++i) { const float keep = up ? a8[4 + i] : a8[i], send = up ? a8[i] : a8[4 + i]; b4[i] = keep + shx(send, 32, lane); } }
            { const bool up = (lane & 16) != 0;
#pragma unroll
              for (int i = 0; i < 2; ++i) { const float keep = up ? b4[2 + i] : b4[i], send = up ? b4[i] : b4[2 + i]; b2[i] = keep + shx(send, 16, lane); } }
            { const bool up = (lane & 8) != 0; const float keep = up ? b2[1] : b2[0], send = up ? b2[0] : b2[1]; b1 = keep + shx(send, 8, lane); }
            b1 += shx(b1, 4, lane); b1 += shx(b1, 2, lane); b1 += shx(b1, 1, lane);
            float lg[NEXP];
#pragma unroll
            for (int e = 0; e < NEXP; ++e) lg[e] = __builtin_bit_cast(float, __builtin_amdgcn_readlane(__builtin_bit_cast(int, b1), ((e >> 2) << 5) | (((e >> 1) & 1) << 4) | ((e & 1) << 3)));
            int i1 = 0; float v1 = lg[0];
#pragma unroll
            for (int e = 1; e < NEXP; ++e) if (lg[e] > v1) { v1 = lg[e]; i1 = e; }
            int i2 = -1; float v2 = -INFINITY;
#pragma unroll
            for (int e = 0; e < NEXP; ++e) if (e != i1 && lg[e] > v2) { v2 = lg[e]; i2 = e; }
            const float e2 = __expf(v2 - v1), g1 = 1.0f / (1.0f + e2), g2 = e2 / (1.0f + e2);
            if (lane == 0) { tok_e[2 * m] = i1; tok_e[2 * m + 1] = i2; tok_g[2 * m] = g1; tok_g[2 * m + 1] = g2; atomicAdd((int*)&lcnt[i1], 1); atomicAdd((int*)&lcnt[i2], 1); }
        }
        __syncthreads();
        if (threadIdx.x < NEXP) cnt[c * NEXP + threadIdx.x] = lcnt[threadIdx.x];
    }
}
__device__ __forceinline__ void moe_assign(const int* cnt, const int* tok_e, const float* tok_g, int* tok_s, int* stok, float* sgate, int* pbase_out, const bf16_t* xn, bf16_t* ag, LAS int* lw, int vb, int G, int wave, int lane) {
    const int tid = wave * 64 + lane;
    for (int c = vb; c < T / 128; c += G) {
        __syncthreads();
        for (int i = tid; i < (T / 128) * NEXP; i += NTHR) lw[i] = cnt[i];
        if (tid < 256) lw[2100 + tid] = tok_e[c * 256 + tid];
        __syncthreads();
        if (tid < NEXP) { const int e = tid; int tot = 0, pre = 0;
            for (int cc = 0; cc < T / 128; ++cc) { const int v = lw[cc * NEXP + e]; tot += v; pre += (cc < c) ? v : 0; }
            lw[2048 + e] = tot; lw[2056 + e] = pre; }
        __syncthreads();
        if (tid == 0) { int pb = 0;
            for (int e = 0; e < NEXP; ++e) { lw[2064 + e] = pb; pb += (lw[2048 + e] + 255) >> 8; }
            lw[2064 + NEXP] = pb;
            if (c == 0) { for (int e = 0; e <= NEXP; ++e) pbase_out[e] = lw[2064 + e]; } }
        __syncthreads();
        if (tid < 256) { const int p = tid, e = lw[2100 + p]; int rank = 0;
            for (int q = 0; q < p; ++q) rank += (lw[2100 + q] == e) ? 1 : 0;
            const int pi = c * 256 + p, s = lw[2064 + e] * 256 + lw[2056 + e] + rank;
            tok_s[pi] = s; stok[s] = pi >> 1; sgate[s] = tok_g[pi]; lw[2400 + p] = s; }
        __syncthreads();
        for (int p = wave * 32; p < wave * 32 + 32; ++p) { const int pi = c * 256 + p; const int s = lw[2400 + p]; const int tk = pi >> 1;
            const u32x4* src = (const u32x4*)(xn + (size_t)tk * D) + lane; u32x4* dst = (u32x4*)(ag + (size_t)s * D) + lane;
            const u32x4 a = src[0], b = src[64]; dst[0] = a; dst[64] = b; }
    }
}
__device__ __forceinline__ void moe_combine(float* out, const bf16_t* xs, int ldx, const bf16_t* Y, const int* tok_s, int gw, int ngw, int lane) {
    for (int m = gw; m < T; m += ngw) {
        const int s0 = tok_s[2 * m], s1 = tok_s[2 * m + 1];
        f32x4* xr = (f32x4*)(out + (size_t)m * D) + lane;
        const u32x2* y0 = (const u32x2*)(Y + (size_t)s0 * D) + lane; const u32x2* y1 = (const u32x2*)(Y + (size_t)s1 * D) + lane;
        f32x4 v[4];
#pragma unroll
        for (int j = 0; j < 4; ++j) v[j] = ldx4<true>(xs, (size_t)m * ldx + 4 * lane + 256 * j);
#pragma unroll
        for (int j = 0; j < 4; ++j) { const u32x2 a = y0[64 * j], b = y1[64 * j];
            v[j].x += bflo(a.x) + bflo(b.x); v[j].y += bfhi(a.x) + bfhi(b.x); v[j].z += bflo(a.y) + bflo(b.y); v[j].w += bfhi(a.y) + bfhi(b.y); }
        asm volatile("s_waitcnt vmcnt(0)" ::: "memory");
#pragma unroll
        for (int j = 0; j < 4; ++j) xr[64 * j] = v[j];
    }
}

__device__ __forceinline__ void ld8(const bf16_t* p, float* f) { const u32x4 w = *(const u32x4*)p; f[0] = bflo(w.x); f[1] = bfhi(w.x); f[2] = bflo(w.y); f[3] = bfhi(w.y); f[4] = bflo(w.z); f[5] = bfhi(w.z); f[6] = bflo(w.w); f[7] = bfhi(w.w); }
__device__ __forceinline__ void st8(bf16_t* p, const float* f) { u32x4 w; w.x = pk2(f[0], f[1]); w.y = pk2(f[2], f[3]); w.z = pk2(f[4], f[5]); w.w = pk2(f[6], f[7]); *(u32x4*)p = w; }

__device__ __forceinline__ void sb_naive(const bf16_t* QA, const bf16_t* KA, const bf16_t* VA, bf16_t* O, int gtid, int gthreads) {
    for (int item = gtid; item < T * 4; item += gthreads) {
        const int t = item % SEQ, h = (item / SEQ) & 3, b = item / (SEQ * 4);
        const size_t row = (size_t)b * SEQ + t;
        float q[64], o[64];
#pragma unroll
        for (int i = 0; i < 8; ++i) ld8(QA + row * 256 + h * 64 + 8 * i, q + 8 * i);
#pragma unroll
        for (int i = 0; i < 64; ++i) o[i] = 0.f;
        float run = 0.f;
        for (int s = t - 1; s >= 0; --s) {
            const size_t kr = ((size_t)b * SEQ + s) * 256 + h * 64;
            float dot = 0.f;
#pragma unroll
            for (int i = 0; i < 8; ++i) { float k[8]; ld8(KA + kr + 8 * i, k);
#pragma unroll
                for (int j = 0; j < 8; ++j) dot += q[8 * i + j] * k[j]; }
            const float z = dot * 0.125f;
            const float l1p = log1pf(expf(-fabsf(z)));
            const float log_beta = fminf(z, 0.f) - l1p, log_keep = fminf(-z, 0.f) - l1p;
            const float att = expf(log_beta + run);
#pragma unroll
            for (int i = 0; i < 8; ++i) { float v[8]; ld8(VA + kr + 8 * i, v);
#pragma unroll
                for (int j = 0; j < 8; ++j) o[8 * i + j] += att * v[j]; }
            run += log_keep;
            if (run < -104.f) break;
        }
#pragma unroll
        for (int i = 0; i < 8; ++i) st8(O + row * D + h * 64 + 8 * i, o + 8 * i);
    }
}
__device__ __forceinline__ void swa_naive(const bf16_t* QC, const bf16_t* KC, const bf16_t* VC, const float* sinks, const LAS float* brel  , bf16_t* O, int gtid, int gthreads) {
    for (int item = gtid; item < T * 8; item += gthreads) {
        const int h = item & 7; const int rowi = item >> 3; const int t = rowi % SEQ, b = rowi / SEQ, kv = h >> 2;
        float q[64], o[64];
#pragma unroll
        for (int i = 0; i < 8; ++i) ld8(QC + (size_t)rowi * 512 + h * 64 + 8 * i, q + 8 * i);
#pragma unroll
        for (int i = 0; i < 64; ++i) o[i] = 0.f;
        float mx = sinks[h], l = 1.0f;
        const int s0 = t - 127 < 0 ? 0 : t - 127;
        for (int s = s0; s <= t; ++s) {
            const size_t kr = ((size_t)b * SEQ + s) * 128 + kv * 64;
            float dot = 0.f;
#pragma unroll
            for (int i = 0; i < 8; ++i) { float k[8]; ld8(KC + kr + 8 * i, k);
#pragma unroll
                for (int j = 0; j < 8; ++j) dot += q[8 * i + j] * k[j]; }
            const float sc = dot * 0.125f + brel[(t - s) * 12 + 4 + h];
            if (sc > mx) { const float f = expf(mx - sc); l *= f;
#pragma unroll
                for (int i = 0; i < 64; ++i) o[i] *= f;
                mx = sc; }
            const float p = expf(sc - mx); l += p;
#pragma unroll
            for (int i = 0; i < 8; ++i) { float v[8]; ld8(VC + kr + 8 * i, v);
#pragma unroll
                for (int j = 0; j < 8; ++j) o[8 * i + j] += p * v[j]; }
        }
        const float il = 1.0f / l;
#pragma unroll
        for (int i = 0; i < 64; ++i) o[i] *= il;
#pragma unroll
        for (int i = 0; i < 8; ++i) st8(O + (size_t)rowi * D + 512 + h * 64 + 8 * i, o + 8 * i);
    }
}
__device__ __forceinline__ void dsa_naive(const bf16_t* QB, const bf16_t* KB, const bf16_t* VB, const bf16_t* QI, const bf16_t* KI, const float* WI, const LAS float* brel, bf16_t* O, LAS unsigned char* wl, int gw, int ngw, int lane) {
    LAS float* sqi = (LAS float*)wl; LAS float* sqb = sqi + 256; LAS int* sidx = (LAS int*)(sqi + 512); LAS float* sp = sqi + 768;
    const unsigned long long ltmask = (1ull << lane) - 1ull;
    for (int qrow = gw; qrow < T; qrow += ngw) {
        const int b = qrow / SEQ, t = qrow % SEQ;
        { const u32x2 a = *(const u32x2*)(QI + (size_t)qrow * 256 + 4 * lane), c = *(const u32x2*)(QB + (size_t)qrow * 256 + 4 * lane);
          sqi[4 * lane] = bflo(a.x); sqi[4 * lane + 1] = bfhi(a.x); sqi[4 * lane + 2] = bflo(a.y); sqi[4 * lane + 3] = bfhi(a.y);
          sqb[4 * lane] = bflo(c.x); sqb[4 * lane + 1] = bfhi(c.x); sqb[4 * lane + 2] = bflo(c.y); sqb[4 * lane + 3] = bfhi(c.y); }
        const f32x4 wi = *(const f32x4*)(WI + (size_t)qrow * 4);
        LDS_WAIT(); asm volatile("" ::: "memory");
        unsigned key[32];
#pragma unroll
        for (int r = 0; r < 32; ++r) {
            key[r] = 0u;
            if (64 * r <= t) {
                const int s = 64 * r + lane;
                if (s <= t) {
                    float dd[4] = {0.f, 0.f, 0.f, 0.f};
#pragma unroll
                    for (int i = 0; i < 8; ++i) { float k[8]; ld8(KI + ((size_t)b * SEQ + s) * 64 + 8 * i, k);
#pragma unroll
                        for (int h = 0; h < 4; ++h)
#pragma unroll
                            for (int j = 0; j < 8; ++j) dd[h] += sqi[h * 64 + 8 * i + j] * k[j]; }
                    float sc = 0.f;
#pragma unroll
                    for (int h = 0; h < 4; ++h) { const float d = dd[h] * 0.125f; sc += wi[h] * (d > 0.f ? d : 0.f); }
                    const unsigned u = __builtin_bit_cast(unsigned, sc);
                    key[r] = (u & 0x80000000u) ? ~u : (u | 0x80000000u);
                }
            }
        }
        const int nvalid = t + 1;
        unsigned tau = 0u; int need = 0;
        if (nvalid > 256) {
            unsigned lo = 0u, hi = 0xFFFFFFFFu;
            while (hi - lo > 1u) { const unsigned mid = lo + ((hi - lo) >> 1); int c = 0;
#pragma unroll
                for (int r = 0; r < 32; ++r) c += __popcll(__ballot(key[r] > mid));
                if (c >= 256) lo = mid; else hi = mid; }
            tau = hi; int ngt = 0;
#pragma unroll
            for (int r = 0; r < 32; ++r) ngt += __popcll(__ballot(key[r] > tau));
            need = 256 - ngt;
        }
        int pos = 0, tie_seen = 0;
#pragma unroll
        for (int r = 0; r < 32; ++r) {
            const bool gt = key[r] > tau; const bool eq = (nvalid > 256) && (key[r] == tau);
            const unsigned long long meq = __ballot(eq);
            const bool sel = gt || (eq && (tie_seen + __popcll(meq & ltmask)) < need);
            tie_seen += __popcll(meq);
            const unsigned long long ms = __ballot(sel);
            if (sel) sidx[pos + __popcll(ms & ltmask)] = 64 * r + lane;
            pos += __popcll(ms);
        }
        const int nsel = pos;
        LDS_WAIT(); asm volatile("" ::: "memory");
        float sc4[4][4];
#pragma unroll
        for (int i = 0; i < 4; ++i) { const int j = lane + 64 * i;
            if (j < nsel) { const int s = sidx[j]; float dd[4] = {0.f, 0.f, 0.f, 0.f};
#pragma unroll
                for (int ii = 0; ii < 8; ++ii) { float k[8]; ld8(KB + ((size_t)b * SEQ + s) * 64 + 8 * ii, k);
#pragma unroll
                    for (int h = 0; h < 4; ++h)
#pragma unroll
                        for (int jj = 0; jj < 8; ++jj) dd[h] += sqb[h * 64 + 8 * ii + jj] * k[jj]; }
                int rel = t - s; rel = rel > 127 ? 127 : rel;
#pragma unroll
                for (int h = 0; h < 4; ++h) sc4[i][h] = dd[h] * 0.125f + brel[rel * 12 + h];
            } else {
#pragma unroll
                for (int h = 0; h < 4; ++h) sc4[i][h] = -INFINITY; } }
#pragma unroll
        for (int h = 0; h < 4; ++h) {
            const float mx = wave_max(fmaxf(fmaxf(sc4[0][h], sc4[1][h]), fmaxf(sc4[2][h], sc4[3][h])), lane);
            float e[4], su = 0.f;
#pragma unroll
            for (int i = 0; i < 4; ++i) { e[i] = expf(sc4[i][h] - mx); su += e[i]; }
            su = wave_sum(su, lane); const float inv = 1.0f / su;
#pragma unroll
            for (int i = 0; i < 4; ++i) sp[h * 256 + lane + 64 * i] = e[i] * inv;
        }
        LDS_WAIT(); asm volatile("" ::: "memory");
        float o[4] = {0.f, 0.f, 0.f, 0.f};
        for (int j = 0; j < nsel; ++j) { const int s = sidx[j]; const float v = bf2f(VB[((size_t)b * SEQ + s) * 64 + lane]);
#pragma unroll
            for (int h = 0; h < 4; ++h) o[h] += sp[h * 256 + j] * v; }
#pragma unroll
        for (int h = 0; h < 4; ++h) O[(size_t)qrow * D + 256 + h * 64 + lane] = (bf16_t)f2bf(o[h]);
        LDS_WAIT(); asm volatile("" ::: "memory");
    }
}
__device__ __forceinline__ float sum16(float v, int lane) { v += shx(v, 1, lane); v += shx(v, 2, lane); v += shx(v, 4, lane); v += shx(v, 8, lane); return v; }
__device__ __forceinline__ void xattn_naive(const bf16_t* QX, const bf16_t* MKV  , const float* qn, bf16_t* OX, int gw, int ngw, int lane) {
    const int h = lane >> 4, part = lane & 15;
    float gq[8];
#pragma unroll
    for (int i = 0; i < 8; ++i) gq[i] = qn[part * 8 + i];
    for (int row = gw; row < T; row += ngw) {
        const int b = row / SEQ;
        float q[8]; ld8(QX + (size_t)row * 512 + h * 128 + part * 8, q);
        float ss = 0.f;
#pragma unroll
        for (int i = 0; i < 8; ++i) ss += q[i] * q[i];
        ss = sum16(ss, lane);
        const float r = 1.0f / sqrtf(ss * (1.0f / 128.0f) + EPS) * 0.08838834764831845f;
#pragma unroll
        for (int i = 0; i < 8; ++i) q[i] = q[i] * r * gq[i];
        float mx = -INFINITY, l = 0.f, o[8];
#pragma unroll
        for (int i = 0; i < 8; ++i) o[i] = 0.f;
        for (int j = 0; j < NMEM; ++j) {
            const bf16_t* kp = MKV + ((size_t)b * NMEM + j) * D + h * 128 + part * 8;
            float k[8], v[8]; ld8(kp, k); ld8(kp + 512, v);
            float d = 0.f;
#pragma unroll
            for (int i = 0; i < 8; ++i) d += q[i] * k[i];
            d = sum16(d, lane);
            if (d > mx) { const float f = expf(mx - d); l *= f;
#pragma unroll
                for (int i = 0; i < 8; ++i) o[i] *= f;
                mx = d; }
            const float p = expf(d - mx); l += p;
#pragma unroll
            for (int i = 0; i < 8; ++i) o[i] += p * v[i];
        }
        const float il = 1.0f / l;
#pragma unroll
        for (int i = 0; i < 8; ++i) o[i] *= il;
        st8(OX + (size_t)row * 512 + h * 128 + part * 8, o);
    }
}
__device__ __forceinline__ void memk_norm(bf16_t* MKV  , const float* kn_x  , int gw, int ngw, int lane) {
    const int h = lane >> 4, part = lane & 15;
    for (int row = gw; row < 2 * TM; row += ngw) {
        const int l = row / TM;
        bf16_t* kp = MKV + (size_t)row * D + h * 128 + part * 8;
        float k[8]; ld8(kp, k);
        float ss = 0.f;
#pragma unroll
        for (int i = 0; i < 8; ++i) ss += k[i] * k[i];
        ss = sum16(ss, lane);
        const float r = 1.0f / sqrtf(ss * (1.0f / 128.0f) + EPS);
#pragma unroll
        for (int i = 0; i < 8; ++i) k[i] = k[i] * r * kn_x[l * 128 + part * 8 + i];
        st8(kp, k);
    }
}
typedef float f32x16 __attribute__((ext_vector_type(16)));
typedef short s16x4 __attribute__((ext_vector_type(4)));
#define LOG2E 1.4426950408889634f
#ifndef KDIRECT
#define KDIRECT 0
#endif
__device__ __forceinline__ f32x16 zero16() { float z = 0.f; asm volatile("" : "+v"(z)); return (f32x16){z, z, z, z, z, z, z, z, z, z, z, z, z, z, z, z}; }
__device__ __forceinline__ int crow(int r, int hi) { return (r & 3) + 8 * (r >> 2) + 4 * hi; }
__device__ __forceinline__ void xhalf_pair(float v, float& own_lo, float& own_hi) { float a = v, b = v;
    asm volatile("s_nop 1\n\tv_permlane32_swap_b32 %0, %1\n\ts_nop 1" : "+v"(a), "+v"(b)); own_lo = a; own_hi = b; }
__device__ __forceinline__ float xhalf_max(float v) { float x, y; xhalf_pair(v, x, y); return fmaxf(x, y); }
__device__ __forceinline__ float xhalf_sum(float v) { float x, y; xhalf_pair(v, x, y); return x + y; }

__device__ __forceinline__ s16x4 vtr(const LAS unsigned char* p) { return __builtin_bit_cast(s16x4, __builtin_amdgcn_ds_read_tr16_b64_v4i16((LAS s16x4*)p)); }
__device__ __forceinline__ bf16x8 mk8(s16x4 lo, s16x4 hi) { return (bf16x8){lo[0], lo[1], lo[2], lo[3], hi[0], hi[1], hi[2], hi[3]}; }
__device__ __forceinline__ bf16x8 pack8(const float* p) { u32x4 w; w.x = cvt_pk_bf16(p[0], p[1]); w.y = cvt_pk_bf16(p[2], p[3]); w.z = cvt_pk_bf16(p[4], p[5]); w.w = cvt_pk_bf16(p[6], p[7]); return __builtin_bit_cast(bf16x8, w); }
__device__ __forceinline__ int vtr_base(int lane, int vstr) { const int hi = lane >> 5, g1 = (lane >> 4) & 1, i = lane & 15; return (4 * hi + (i >> 2)) * vstr + (16 * g1 + 4 * (i & 3)) * 2; }

__device__ __forceinline__ void xattn_mfma(const bf16_t* QX, const bf16_t* MKV, const float* qn, bf16_t* OX, LAS unsigned char* lds, int vcu, int G, int tid) {
    const int lane = tid & 63, wave = __builtin_amdgcn_readfirstlane(tid >> 6), c = lane & 31, hi = lane >> 5;
    constexpr int KSTR = 272, VSTR = 320, VOFF = 256 * KSTR;
    const int vb = VOFF + vtr_base(lane, VSTR);
    for (int unit = vcu; unit < BATCH * 4 * 8; unit += G) {
        const int b = unit >> 5, h = (unit >> 3) & 3, qb = unit & 7;
        const size_t qrow = (size_t)b * SEQ + qb * 256 + wave * 32 + c;
        __syncthreads();
#pragma unroll 4
        for (int i = 0; i < 8; ++i) { const int id = tid + 512 * i, row = id >> 4, ch = id & 15;
            const bf16_t* src = MKV + ((size_t)(b * NMEM + row)) * D + h * 128 + ch * 8;
            *(LAS u32x4*)(lds + row * KSTR + ch * 16) = *(const u32x4*)src; }
        asm volatile("" ::: "memory");
#pragma unroll 4
        for (int i = 0; i < 8; ++i) { const int id = tid + 512 * i, row = id >> 4, ch = id & 15;
            const bf16_t* src = MKV + ((size_t)(b * NMEM + row)) * D + 512 + h * 128 + ch * 8;
            *(LAS u32x4*)(lds + VOFF + row * VSTR + ch * 16) = *(const u32x4*)src; }
        asm volatile("" ::: "memory");
        bf16x8 qf[8];
        { float q[8][8]; float ss = 0.f;
#pragma unroll
          for (int ks = 0; ks < 8; ++ks) { ld8(QX + qrow * 512 + h * 128 + 16 * ks + 8 * hi, q[ks]);
#pragma unroll
              for (int j = 0; j < 8; ++j) ss += q[ks][j] * q[ks][j]; }
          ss = xhalf_sum(ss);
          const float r = 1.0f / sqrtf(ss * (1.0f / 128.0f) + EPS) * (0.08838834764831845f * LOG2E);
#pragma unroll
          for (int ks = 0; ks < 8; ++ks) { float t[8];
#pragma unroll
              for (int j = 0; j < 8; ++j) t[j] = q[ks][j] * r * qn[16 * ks + 8 * hi + j];
              qf[ks] = pack8(t); } }
        __syncthreads();
        f32x16 O[4];
#pragma unroll
        for (int dt = 0; dt < 4; ++dt) O[dt] = zero16();
        float m = -1e30f, l = 0.f;
        for (int kt = 0; kt < 8; ++kt) {
            f32x16 S = zero16();
#pragma unroll
            for (int ks = 0; ks < 8; ++ks) {
#if KDIRECT
                const bf16x8 kf = *(const bf16x8*)(MKV + ((size_t)(b * NMEM + kt * 32 + c)) * D + h * 128 + 16 * ks + 8 * hi);
#else
                const bf16x8 kf = *(const LAS bf16x8*)(lds + (kt * 32 + c) * KSTR + (16 * ks + 8 * hi) * 2);
#endif
                S = __builtin_amdgcn_mfma_f32_32x32x16_bf16(kf, qf[ks], S, 0, 0, 0); }
            float tm = S[0];
#pragma unroll
            for (int r = 1; r < 16; ++r) tm = fmaxf(tm, S[r]);
            const float mn = fmaxf(m, xhalf_max(tm));
            const float f = __builtin_amdgcn_exp2f(m - mn); m = mn;
            float p[16], ps = 0.f;
#pragma unroll
            for (int r = 0; r < 16; ++r) { p[r] = __builtin_amdgcn_exp2f(S[r] - mn); ps += p[r]; }
            l = l * f + ps;
#pragma unroll
            for (int dt = 0; dt < 4; ++dt) O[dt] *= f;
            const bf16x8 pf0 = pack8(p), pf1 = pack8(p + 8);
#pragma unroll
            for (int dt = 0; dt < 4; ++dt) { const LAS unsigned char* vp = lds + vb + (kt * 32) * VSTR + dt * 64;
                const bf16x8 v0 = mk8(vtr(vp), vtr(vp + 8 * VSTR)), v1 = mk8(vtr(vp + 16 * VSTR), vtr(vp + 24 * VSTR));
                O[dt] = __builtin_amdgcn_mfma_f32_32x32x16_bf16(v0, pf0, O[dt], 0, 0, 0);
                O[dt] = __builtin_amdgcn_mfma_f32_32x32x16_bf16(v1, pf1, O[dt], 0, 0, 0); }
        }
        const float il = 1.0f / xhalf_sum(l);
#pragma unroll
        for (int dt = 0; dt < 4; ++dt)
#pragma unroll
            for (int g = 0; g < 4; ++g) { u32x2 w; w.x = cvt_pk_bf16(O[dt][4 * g] * il, O[dt][4 * g + 1] * il); w.y = cvt_pk_bf16(O[dt][4 * g + 2] * il, O[dt][4 * g + 3] * il);
                *(u32x2*)(OX + qrow * 512 + h * 128 + dt * 32 + 8 * g + 4 * hi) = w; }
    }
}

__device__ __forceinline__ void swa_mfma(const bf16_t* QC, const bf16_t* KC, const bf16_t* VC, const float* sinks, const LAS float* brel, bf16_t* O, LAS unsigned char* lds, int vcu, int G, int tid) {
    const int lane = tid & 63, wave = __builtin_amdgcn_readfirstlane(tid >> 6), c = lane & 31, hi = lane >> 5;
    constexpr int KSTR = 144, VSTR = 192, VOFF = 192 * KSTR;
    const int vb = VOFF + vtr_base(lane, VSTR);
    const int g = wave >> 1, qh = wave & 1;
    for (int unit = vcu; unit < BATCH * 2 * 32; unit += G) {
        const int b = unit >> 6, kvh = (unit >> 5) & 1, qb = unit & 31, q0 = qb * 64, head = kvh * 4 + g;
        __syncthreads();
#pragma unroll
        for (int i = 0; i < 3; ++i) { const int id = tid + 512 * i, row = id >> 3, ch = id & 7; int kr = q0 - 128 + row; kr = kr < 0 ? 0 : kr;
            const size_t src = ((size_t)b * SEQ + kr) * 128 + kvh * 64 + ch * 8;
            *(LAS u32x4*)(lds + row * KSTR + ch * 16) = *(const u32x4*)(KC + src);
            *(LAS u32x4*)(lds + VOFF + row * VSTR + ch * 16) = *(const u32x4*)(VC + src); }
        const int t = q0 + 32 * qh + c; const size_t qrow = (size_t)b * SEQ + t;
        bf16x8 qf[4];
#pragma unroll
        for (int ks = 0; ks < 4; ++ks) qf[ks] = *(const bf16x8*)(QC + qrow * 512 + head * 64 + 16 * ks + 8 * hi);
        const float sink = sinks[head] * LOG2E;
        __syncthreads();
        f32x16 Oa[2];
#pragma unroll
        for (int dt = 0; dt < 2; ++dt) Oa[dt] = zero16();
        float m = sink, l = 0.5f;
        const int rb = c + 128 - 4 * hi;
        const int sp0 = q0 - 128 + 32 * qh + 4 * hi;
        const LAS float* bh = brel + 4 + head;
        for (int kt = 0; kt < 5; ++kt) {
            f32x16 S = zero16();
#pragma unroll
            for (int ks = 0; ks < 4; ++ks) {
#if KDIRECT
                int kr = q0 - 128 + (kt + qh) * 32 + c; kr = kr < 0 ? 0 : kr;
                const bf16x8 kf = *(const bf16x8*)(KC + ((size_t)b * SEQ + kr) * 128 + kvh * 64 + 16 * ks + 8 * hi);
#else
                const bf16x8 kf = *(const LAS bf16x8*)(lds + ((kt + qh) * 32 + c) * KSTR + (16 * ks + 8 * hi) * 2);
#endif
                S = __builtin_amdgcn_mfma_f32_32x32x16_bf16(kf, qf[ks], S, 0, 0, 0); }
            float sv[16], tm = -1e30f;
#pragma unroll
            for (int r = 0; r < 16; ++r) { const int cr = 32 * kt + (r & 3) + 8 * (r >> 2);
                const int rel = rb - cr, spos = sp0 + cr;
                const int inv = (rel | (127 - rel) | spos) >> 31;
                const int relc = rel < 0 ? 0 : (rel > 127 ? 127 : rel);
                const float v = S[r] * (0.125f * LOG2E) + bh[relc * 12] * LOG2E;
                const float cap = __builtin_bit_cast(float, 0x7F800000u | ((unsigned)inv & 0x80000000u));
                sv[r] = fminf(v, cap); tm = fmaxf(tm, sv[r]); }
            const float mn = fmaxf(m, xhalf_max(tm));
            const float f = __builtin_amdgcn_exp2f(m - mn); m = mn;
            float p[16], ps = 0.f;
#pragma unroll
            for (int r = 0; r < 16; ++r) { p[r] = __builtin_amdgcn_exp2f(sv[r] - mn); ps += p[r]; }
            l = l * f + ps;
#pragma unroll
            for (int dt = 0; dt < 2; ++dt) Oa[dt] *= f;
            const bf16x8 pf0 = pack8(p), pf1 = pack8(p + 8);
#pragma unroll
            for (int dt = 0; dt < 2; ++dt) { const LAS unsigned char* vp = lds + vb + ((kt + qh) * 32) * VSTR + dt * 64;
                const bf16x8 v0 = mk8(vtr(vp), vtr(vp + 8 * VSTR)), v1 = mk8(vtr(vp + 16 * VSTR), vtr(vp + 24 * VSTR));
                Oa[dt] = __builtin_amdgcn_mfma_f32_32x32x16_bf16(v0, pf0, Oa[dt], 0, 0, 0);
                Oa[dt] = __builtin_amdgcn_mfma_f32_32x32x16_bf16(v1, pf1, Oa[dt], 0, 0, 0); }
        }
        const float il = 1.0f / xhalf_sum(l);
#pragma unroll
        for (int dt = 0; dt < 2; ++dt)
#pragma unroll
            for (int gg = 0; gg < 4; ++gg) { u32x2 w; w.x = cvt_pk_bf16(Oa[dt][4 * gg] * il, Oa[dt][4 * gg + 1] * il); w.y = cvt_pk_bf16(Oa[dt][4 * gg + 2] * il, Oa[dt][4 * gg + 3] * il);
                *(u32x2*)(O + qrow * D + 512 + head * 64 + dt * 32 + 8 * gg + 4 * hi) = w; }
    }
}

__device__ __forceinline__ float log_sig(float z, float l1p) { return fminf(z, 0.f) - l1p; }
__device__ __forceinline__ void sb_mfma(const bf16_t* QA, const bf16_t* KA, const bf16_t* VA, bf16_t* O, LAS unsigned char* wl, int gw, int ngw, int lane) {
    const int c = lane & 31, hi = lane >> 5;
    constexpr int VSTR = 192;
    const int vb = vtr_base(lane, VSTR);
    for (int item = gw; item < BATCH * 4 * 64; item += ngw) {
        const int b = item >> 8, h = (item >> 6) & 3, qb = item & 63, q0 = qb * 32;
        const size_t qrow = (size_t)b * SEQ + q0 + c;
        bf16x8 qf[4];
#pragma unroll
        for (int ks = 0; ks < 4; ++ks) qf[ks] = *(const bf16x8*)(QA + qrow * 256 + h * 64 + 16 * ks + 8 * hi);
        f32x16 Oa[2];
#pragma unroll
        for (int dt = 0; dt < 2; ++dt) Oa[dt] = zero16();
        float carry = 0.f;
        bf16x8 kf[4], kn[4] = {}; u32x4 vr[4], vn[4] = {};
        { const size_t krow0 = (size_t)b * SEQ + qb * 32;
#pragma unroll
          for (int ks = 0; ks < 4; ++ks) kf[ks] = *(const bf16x8*)(KA + (krow0 + c) * 256 + h * 64 + 16 * ks + 8 * hi);
#pragma unroll
          for (int i = 0; i < 4; ++i) { const int id = lane + 64 * i, row = id >> 3, ch = id & 7; vr[i] = *(const u32x4*)(VA + (krow0 + row) * 256 + h * 64 + ch * 8); } }
        for (int kt = qb; kt >= 0; --kt) {
#pragma unroll
            for (int i = 0; i < 4; ++i) { const int id = lane + 64 * i, row = id >> 3, ch = id & 7; *(LAS u32x4*)(wl + row * VSTR + ch * 16) = vr[i]; }
            if (kt > 0) { const size_t krow1 = (size_t)b * SEQ + (kt - 1) * 32;
#pragma unroll
                for (int ks = 0; ks < 4; ++ks) kn[ks] = *(const bf16x8*)(KA + (krow1 + c) * 256 + h * 64 + 16 * ks + 8 * hi);
#pragma unroll
                for (int i = 0; i < 4; ++i) { const int id = lane + 64 * i, row = id >> 3, ch = id & 7; vn[i] = *(const u32x4*)(VA + (krow1 + row) * 256 + h * 64 + ch * 8); } }
            f32x16 S = zero16();
#pragma unroll
            for (int ks = 0; ks < 4; ++ks) S = __builtin_amdgcn_mfma_f32_32x32x16_bf16(kf[ks], qf[ks], S, 0, 0, 0);
            const bool diag = (kt == qb);
            float lk[16], lb[16];
            const int dm = diag ? (c - 1 - 4 * hi) : 64;
#pragma unroll
            for (int r = 0; r < 16; ++r) { const float z = S[r] * 0.125f; const float l1p = 0.6931471805599453f * __builtin_amdgcn_logf(1.0f + __builtin_amdgcn_exp2f(fabsf(z) * -1.4426950408889634f));
                const int inv = (dm - ((r & 3) + 8 * (r >> 2))) >> 31;
                const float cap = __builtin_bit_cast(float, 0x7F800000u | ((unsigned)inv & 0x80000000u));
                lb[r] = fminf(log_sig(z, l1p), cap);
                lk[r] = __builtin_bit_cast(float, __builtin_bit_cast(unsigned, log_sig(-z, l1p)) & ~(unsigned)inv); }
            float gs[4], go[4];
#pragma unroll
            for (int q = 0; q < 4; ++q) { gs[q] = (lk[4 * q] + lk[4 * q + 1]) + (lk[4 * q + 2] + lk[4 * q + 3]);
                float x, y; xhalf_pair(gs[q], x, y); go[q] = hi ? x : y; }
            float suf[4];
            { float a = 0.f;
#pragma unroll
              for (int q = 3; q >= 0; --q) {
                  suf[q] = a + (hi ? 0.f : go[q]);
                  a += gs[q] + go[q]; }
              float p[16];
#pragma unroll
              for (int q = 0; q < 4; ++q) { float w = suf[q] + carry;
#pragma unroll
                  for (int i = 3; i >= 0; --i) { p[4 * q + i] = __expf(lb[4 * q + i] + w); w += lk[4 * q + i]; } }
              carry += a;
              asm volatile("s_waitcnt lgkmcnt(0)" ::: "memory");
              const bf16x8 pf0 = pack8(p), pf1 = pack8(p + 8);
#pragma unroll
              for (int dt = 0; dt < 2; ++dt) { const LAS unsigned char* vp = wl + vb + dt * 64;
                  const bf16x8 v0 = mk8(vtr(vp), vtr(vp + 8 * VSTR)), v1 = mk8(vtr(vp + 16 * VSTR), vtr(vp + 24 * VSTR));
                  Oa[dt] = __builtin_amdgcn_mfma_f32_32x32x16_bf16(v0, pf0, Oa[dt], 0, 0, 0);
                  Oa[dt] = __builtin_amdgcn_mfma_f32_32x32x16_bf16(v1, pf1, Oa[dt], 0, 0, 0); }
              asm volatile("s_waitcnt lgkmcnt(0)" ::: "memory"); }
#pragma unroll
            for (int i = 0; i < 4; ++i) { kf[i] = kn[i]; vr[i] = vn[i]; }
            if (__all(carry < -104.f)) break;
        }
#pragma unroll
        for (int dt = 0; dt < 2; ++dt)
#pragma unroll
            for (int gg = 0; gg < 4; ++gg) { u32x2 w; w.x = cvt_pk_bf16(Oa[dt][4 * gg], Oa[dt][4 * gg + 1]); w.y = cvt_pk_bf16(Oa[dt][4 * gg + 2], Oa[dt][4 * gg + 3]);
                *(u32x2*)(O + qrow * D + h * 64 + dt * 32 + 8 * gg + 4 * hi) = w; }
    }
}

__device__ __forceinline__ void dsa_mfma(const bf16_t* QB, const bf16_t* KB, const bf16_t* VB, const bf16_t* QI, const bf16_t* KI, const float* WI, const LAS float* brel, bf16_t* O, LAS unsigned char* lds, int vcu, int G, int tid) {
    const int lane = tid & 63, wave = __builtin_amdgcn_readfirstlane(tid >> 6), c = lane & 31, hi = lane >> 5, c16 = lane & 15, g4 = lane >> 4;
    constexpr int SCSTR = 2052, BM_OFF = 16 * SCSTR * 4, BMSTR = 65, VSTR = 192;
    LAS float* sc = (LAS float*)lds; LAS unsigned* bm = (LAS unsigned*)(lds + BM_OFF); LAS unsigned* hist = (LAS unsigned*)(lds + 154624 + wave * 1024);
    LAS unsigned char* wl = lds + wave * 6144;
    const int vb = vtr_base(lane, VSTR);
    const unsigned long long ltmask = (1ull << lane) - 1ull;
    for (int item = vcu; item < BATCH * 16; item += G) {
      const int b = item >> 4, sidx = item & 15;
      for (int u = 0; u < 2; ++u) {
        const int qb = u == 0 ? sidx : 31 - sidx, q0 = qb * 64;
        for (int sub = 0; sub < 4; ++sub) {
            const int q0s = q0 + 16 * sub;
            __syncthreads();
            {
                const size_t qrow = (size_t)b * SEQ + q0s + c16;
                bf16x8 qf[4][2];
#pragma unroll
                for (int h = 0; h < 4; ++h)
#pragma unroll
                    for (int ks = 0; ks < 2; ++ks) qf[h][ks] = *(const bf16x8*)(QI + qrow * 256 + h * 64 + 32 * ks + 8 * g4);
                const f32x4 wi = *(const f32x4*)(WI + qrow * 4);
                const int nt16 = (q0s >> 4) + 1, tq = q0s + c16;
                bf16x8 kf[2][2] = {}, kn[2][2] = {};
#pragma unroll
                for (int j = 0; j < 2; ++j) if (wave + 8 * j < nt16) {
#pragma unroll
                    for (int ks = 0; ks < 2; ++ks) kf[j][ks] = *(const bf16x8*)(KI + ((size_t)b * SEQ + (wave + 8 * j) * 16 + c16) * 64 + 32 * ks + 8 * g4); }
                for (int kt = wave; kt < nt16; kt += 16) {
#pragma unroll
                    for (int j = 0; j < 2; ++j) if (kt + 16 + 8 * j < nt16) {
#pragma unroll
                        for (int ks = 0; ks < 2; ++ks) kn[j][ks] = *(const bf16x8*)(KI + ((size_t)b * SEQ + (kt + 16 + 8 * j) * 16 + c16) * 64 + 32 * ks + 8 * g4); }
#pragma unroll
                    for (int j = 0; j < 2; ++j) if (kt + 8 * j < nt16) {
                        const int key0 = (kt + 8 * j) * 16;
                        f32x4 s4 = {0.f, 0.f, 0.f, 0.f};
#pragma unroll
                        for (int h = 0; h < 4; ++h) { float z = 0.f; asm volatile("" : "+v"(z)); f32x4 a = {z, z, z, z};
                            a = __builtin_amdgcn_mfma_f32_16x16x32_bf16(kf[j][0], qf[h][0], a, 0, 0, 0);
                            a = __builtin_amdgcn_mfma_f32_16x16x32_bf16(kf[j][1], qf[h][1], a, 0, 0, 0);
#pragma unroll
                            for (int r = 0; r < 4; ++r) { const float d = a[r] * 0.125f; s4[r] += wi[h] * (d > 0.f ? d : 0.f); } }
#pragma unroll
                        for (int r = 0; r < 4; ++r) if (key0 + 4 * g4 + r > tq) s4[r] = -INFINITY;
                        *(LAS f32x4*)(sc + c16 * SCSTR + key0 + 4 * g4) = s4; }
#pragma unroll
                    for (int j = 0; j < 2; ++j) { kf[j][0] = kn[j][0]; kf[j][1] = kn[j][1]; }
                }
            }
            __syncthreads();
            for (int qq = 0; qq < 2; ++qq) {
                const int ql = 2 * wave + qq, t = q0s + ql;
                float v[32];
#pragma unroll
                for (int r = 0; r < 32; ++r) { const int s = 64 * r + lane; const float x = sc[ql * SCSTR + s]; v[r] = (s <= t) ? x : -INFINITY; }
                const int nvalid = t + 1;
                float tau = -INFINITY; int need = 0;
#define DSA_CMP8(b, thr, M) asm volatile("v_cmp_gt_f32_e64 %0, %9, %8\n\tv_cmp_gt_f32_e64 %1, %10, %8\n\tv_cmp_gt_f32_e64 %2, %11, %8\n\tv_cmp_gt_f32_e64 %3, %12, %8\n\t" \
        "v_cmp_gt_f32_e64 %4, %13, %8\n\tv_cmp_gt_f32_e64 %5, %14, %8\n\tv_cmp_gt_f32_e64 %6, %15, %8\n\tv_cmp_gt_f32_e64 %7, %16, %8" \
        : "=s"(M[0]), "=s"(M[1]), "=s"(M[2]), "=s"(M[3]), "=s"(M[4]), "=s"(M[5]), "=s"(M[6]), "=s"(M[7]) \
        : "v"(thr), "v"(v[b]), "v"(v[b + 1]), "v"(v[b + 2]), "v"(v[b + 3]), "v"(v[b + 4]), "v"(v[b + 5]), "v"(v[b + 6]), "v"(v[b + 7]))
#define DSA_COUNT_GT(dst, thr) do { const float _t = (thr); int _c = 0; _Pragma("unroll") for (int _g = 0; _g < 4; ++_g) { unsigned long long _m[8]; DSA_CMP8(8 * _g, _t, _m); \
        _c += (__popcll(_m[0]) + __popcll(_m[1])) + (__popcll(_m[2]) + __popcll(_m[3])) + ((__popcll(_m[4]) + __popcll(_m[5])) + (__popcll(_m[6]) + __popcll(_m[7]))); } dst = _c; } while (0)
                if (nvalid > 256) {
                    float mx = -INFINITY, mn = INFINITY;
#pragma unroll
                    for (int r = 0; r < 32; ++r) { mx = fmaxf(mx, v[r]); mn = fminf(mn, (64 * r + lane <= t) ? v[r] : INFINITY); }
                    mx = wave_max(mx, lane); mn = -wave_max(-mn, lane);
                    int cmin; DSA_COUNT_GT(cmin, mn);
                    if (cmin < 256) { tau = mn; need = 256 - cmin; }
                    else {
                        float lo = mn, hi = mx, flo = (float)cmin - 255.5f, fhi = -255.5f; bool done = false;
                        if (lo < 0.f && hi >= 0.f) {
                            int cg, ce = 0; DSA_COUNT_GT(cg, 0.f);
#pragma unroll
                            for (int r = 0; r < 32; ++r) ce += __popcll(__ballot(v[r] >= 0.f));
                            if (cg < 256 && ce >= 256) { tau = 0.f; need = 256 - cg; done = true; }
                            else if (cg >= 256) { lo = 0.f; flo = (float)cg - 255.5f; }
                            else { hi = 0.f; fhi = (float)cg - 255.5f; } }
                        int side = 0;
                        for (int it = 0; it < 24 && !done; ++it) {
                            float p = (it < 2) ? lo + (hi - lo) * 0.5f : lo + (hi - lo) * (flo * __builtin_amdgcn_rcpf(flo - fhi));
                            if (!(p > lo && p < hi)) { p = lo + (hi - lo) * 0.5f;
                                if (!(p > lo && p < hi)) { tau = hi; int c; DSA_COUNT_GT(c, hi); need = 256 - c; done = true; break; } }
                            int c; DSA_COUNT_GT(c, p);
                            if (c == 256) { tau = p; need = 0; done = true; }
                            else if (c > 256) { lo = p; flo = (float)c - 255.5f; if (side > 0) fhi *= 0.5f; side = 1; }
                            else { hi = p; fhi = (float)c - 255.5f; if (side < 0) flo *= 0.5f; side = -1; } }
                        if (!done) {
                            auto okey = [](float f) { const unsigned u = __builtin_bit_cast(unsigned, f); return (u & 0x80000000u) ? ~u : (u | 0x80000000u); };
                            auto ofloat = [](unsigned k) { const unsigned u = (k & 0x80000000u) ? (k & 0x7FFFFFFFu) : ~k; return __builtin_bit_cast(float, u); };
                            unsigned kl = okey(lo), kh = okey(hi);
                            while (kh - kl > 1u) { const unsigned km = kl + ((kh - kl) >> 1); const float mid = ofloat(km); int c; DSA_COUNT_GT(c, mid);
                                if (c >= 256) kl = km; else kh = km; }
                            tau = ofloat(kh); int c; DSA_COUNT_GT(c, tau); need = 256 - c; if (need < 0) need = 0;
                        }
                    }
                }
#undef DSA_COUNT_GT
#undef DSA_CMP8
                unsigned mylo = 0u, myhi = 0u;
                if (need == 0) {
#pragma unroll
                    for (int r = 0; r < 32; ++r) { const unsigned long long ms = __ballot(v[r] > tau); if (lane == r) { mylo = (unsigned)ms; myhi = (unsigned)(ms >> 32); } }
                } else {
                    int tie_seen = 0;
#pragma unroll
                    for (int r = 0; r < 32; ++r) {
                        const bool gt = v[r] > tau; const bool eq = (v[r] == tau);
                        const unsigned long long meq = __ballot(eq);
                        const bool sel = gt || (eq && (tie_seen + __popcll(meq & ltmask)) < need);
                        tie_seen += __popcll(meq);
                        const unsigned long long ms = __ballot(sel);
                        if (lane == r) { mylo = (unsigned)ms; myhi = (unsigned)(ms >> 32); }
                    }
                }
                if (lane < 32) { bm[(16 * sub + ql) * BMSTR + 2 * lane] = mylo; bm[(16 * sub + ql) * BMSTR + 2 * lane + 1] = myhi; }
            }
        }
        __syncthreads();
        {
            const int head = wave >> 1, qh = wave & 1, t = q0 + 32 * qh + c;
            const size_t qrow = (size_t)b * SEQ + t;
            bf16x8 qf[4];
#pragma unroll
            for (int ks = 0; ks < 4; ++ks) qf[ks] = *(const bf16x8*)(QB + qrow * 256 + head * 64 + 16 * ks + 8 * hi);
            f32x16 Oa[2];
#pragma unroll
            for (int dt = 0; dt < 2; ++dt) Oa[dt] = zero16();
            float m = -1e30f, l = 0.f;
            const float bfar = brel[127 * 12 + head] * LOG2E;
            const LAS float* bh = brel + head;
            const int ntile = 2 * qb + qh + 1;
            bf16x8 kf[4], kn[4] = {}; u32x4 vr[4], vn[4] = {};
            { const size_t krow0 = (size_t)b * SEQ;
#pragma unroll
              for (int ks = 0; ks < 4; ++ks) kf[ks] = *(const bf16x8*)(KB + (krow0 + c) * 64 + 16 * ks + 8 * hi);
#pragma unroll
              for (int i = 0; i < 4; ++i) { const int id = lane + 64 * i, row = id >> 3, ch = id & 7; vr[i] = *(const u32x4*)(VB + (krow0 + row) * 64 + ch * 8); } }
            for (int kt = 0; kt < ntile; ++kt) {
#pragma unroll
                for (int i = 0; i < 4; ++i) { const int id = lane + 64 * i, row = id >> 3, ch = id & 7; *(LAS u32x4*)(wl + row * VSTR + ch * 16) = vr[i]; }
                if (kt + 1 < ntile) { const size_t krow1 = (size_t)b * SEQ + (kt + 1) * 32;
#pragma unroll
                    for (int ks = 0; ks < 4; ++ks) kn[ks] = *(const bf16x8*)(KB + (krow1 + c) * 64 + 16 * ks + 8 * hi);
#pragma unroll
                    for (int i = 0; i < 4; ++i) { const int id = lane + 64 * i, row = id >> 3, ch = id & 7; vn[i] = *(const u32x4*)(VB + (krow1 + row) * 64 + ch * 8); } }
                const unsigned word = bm[(32 * qh + c) * BMSTR + kt] >> (4 * hi);
                f32x16 S = zero16();
#pragma unroll
                for (int ks = 0; ks < 4; ++ks) S = __builtin_amdgcn_mfma_f32_32x32x16_bf16(kf[ks], qf[ks], S, 0, 0, 0);
                const bool far = (32 * kt + 31 + 113 <= q0 + 32 * qh);
                const int rb = t - 32 * kt - 4 * hi;
                float sv[16], tm = -1e30f;
#pragma unroll
                for (int r = 0; r < 16; ++r) { const int cr = (r & 3) + 8 * (r >> 2);
                    float bias = bfar;
                    if (!far) { int rel = rb - cr; rel = rel < 0 ? 0 : (rel > 127 ? 127 : rel); bias = bh[rel * 12] * LOG2E; }
                    const float v = S[r] * (0.125f * LOG2E) + bias;
                    const unsigned selbit = (word >> cr) & 1u;
                    const float cap = __builtin_bit_cast(float, 0xFF800000u ^ (selbit << 31));
                    sv[r] = fminf(v, cap); tm = fmaxf(tm, sv[r]); }
                const float mn = fmaxf(m, xhalf_max(tm));
                const float f = __builtin_amdgcn_exp2f(m - mn); m = mn;
                float p[16], ps = 0.f;
#pragma unroll
                for (int r = 0; r < 16; ++r) { p[r] = __builtin_amdgcn_exp2f(sv[r] - mn); ps += p[r]; }
                l = l * f + ps;
#pragma unroll
                for (int dt = 0; dt < 2; ++dt) Oa[dt] *= f;
                const bf16x8 pf0 = pack8(p), pf1 = pack8(p + 8);
                asm volatile("s_waitcnt lgkmcnt(0)" ::: "memory");
#pragma unroll
                for (int dt = 0; dt < 2; ++dt) { const LAS unsigned char* vp = wl + vb + dt * 64;
                    const bf16x8 v0 = mk8(vtr(vp), vtr(vp + 8 * VSTR)), v1 = mk8(vtr(vp + 16 * VSTR), vtr(vp + 24 * VSTR));
                    Oa[dt] = __builtin_amdgcn_mfma_f32_32x32x16_bf16(v0, pf0, Oa[dt], 0, 0, 0);
                    Oa[dt] = __builtin_amdgcn_mfma_f32_32x32x16_bf16(v1, pf1, Oa[dt], 0, 0, 0); }
                asm volatile("s_waitcnt lgkmcnt(0)" ::: "memory");
#pragma unroll
                for (int i = 0; i < 4; ++i) { kf[i] = kn[i]; vr[i] = vn[i]; }
            }
            const float il = 1.0f / xhalf_sum(l);
#pragma unroll
            for (int dt = 0; dt < 2; ++dt)
#pragma unroll
                for (int gg = 0; gg < 4; ++gg) { u32x2 w; w.x = cvt_pk_bf16(Oa[dt][4 * gg] * il, Oa[dt][4 * gg + 1] * il); w.y = cvt_pk_bf16(Oa[dt][4 * gg + 2] * il, Oa[dt][4 * gg + 3] * il);
                    *(u32x2*)(O + qrow * D + 256 + head * 64 + dt * 32 + 8 * gg + 4 * hi) = w; }
        }
      }
    }
}
#ifndef EN_MASK
#define EN_MASK 0xFFFFFFFFu
#endif
#define EN(k) (((EN_MASK) >> (k)) & 1u)
#ifndef DUPMASK
#define DUPMASK 0u
#endif
#define NREP(k) ((((DUPMASK) >> (k)) & 1u) ? 2 : 1)
#ifndef USE_DSA_MFMA
#define USE_DSA_MFMA 1
#endif
#ifndef USE_X_MFMA
#define USE_X_MFMA 1
#endif
#ifndef USE_SWA_MFMA
#define USE_SWA_MFMA 1
#endif
#ifndef USE_SB_MFMA
#define USE_SB_MFMA 1
#endif
#ifndef MK_ONE_LAUNCH
#define MK_ONE_LAUNCH 1
#endif
enum { I_X = 0, I_MEM, I_RELB, I_NMIX, I_WIN, I_BGATE, I_QNDSA, I_KNDSA, I_QNSWA, I_KNSWA, I_SINKS, I_WPA, I_WPB, I_WPC, I_WOUT, I_NX, I_NMEM, I_WXQ, I_WXKV, I_WXO, I_QNX, I_KNX, I_NFFN, I_WGUD, I_WDND, I_WR, I_WGUM, I_WDNM, N_INPUTS };
struct Args { const float* in[N_INPUTS]; float* out; unsigned char* ws; int ph_lo, ph_hi, pad0, pad1; };
constexpr int N_PHASES = 1 + 16 * DEPTH;

template <class AP> __device__ __forceinline__ bool get_cvt_job(AP ap, bf16_t* Wb, int j, CvtJob& J) {
    J.dff = 0; J.kd0 = 0; J.map = 0;
    if (j < 16) { const int l = j >> 3, k = j & 7;
        switch (k) {
        case 0: J.W = ap->in[I_WIN] + (size_t)l * D * NIN; J.K = D; J.Nsrc = NIN; J.Ndst = NINP; J.ldd = D; J.map = 1; J.WT = Wb + WO_IN + (size_t)l * NINP * D; break;
        case 1: J.W = ap->in[I_WPA] + (size_t)l * 256 * D; J.K = 256; J.Nsrc = D; J.Ndst = D; J.ldd = D; J.kd0 = 0;   J.WT = Wb + WO_P + (size_t)l * D * D; break;
        case 2: J.W = ap->in[I_WPB] + (size_t)l * 256 * D; J.K = 256; J.Nsrc = D; J.Ndst = D; J.ldd = D; J.kd0 = 256; J.WT = Wb + WO_P + (size_t)l * D * D; break;
        case 3: J.W = ap->in[I_WPC] + (size_t)l * 512 * D; J.K = 512; J.Nsrc = D; J.Ndst = D; J.ldd = D; J.kd0 = 512; J.WT = Wb + WO_P + (size_t)l * D * D; break;
        case 4: J.W = ap->in[I_WOUT] + (size_t)l * D * D;  J.K = D; J.Nsrc = D; J.Ndst = D; J.ldd = D; J.WT = Wb + WO_OUT + (size_t)l * D * D; break;
        case 5: J.W = ap->in[I_WXQ] + (size_t)l * D * 512; J.K = D; J.Nsrc = 512; J.Ndst = 512; J.ldd = D; J.WT = Wb + WO_XQ + (size_t)l * 512 * D; break;
        case 6: J.W = ap->in[I_WXKV] + (size_t)l * D * D;  J.K = D; J.Nsrc = D; J.Ndst = D; J.ldd = D; J.WT = Wb + WO_XKV + (size_t)l * D * D; break;
        default: J.W = ap->in[I_WXO] + (size_t)l * 512 * D; J.K = 512; J.Nsrc = D; J.Ndst = D; J.ldd = 512; J.WT = Wb + WO_XO + (size_t)l * D * 512; break;
        }
        return true; }
    if (j == 16) { J.W = ap->in[I_WGUD]; J.K = D; J.Nsrc = 2 * DFF; J.Ndst = 2 * DFF; J.ldd = D; J.map = 2; J.dff = DFF; J.WT = Wb + WO_GUD; return true; }
    if (j == 17) { J.W = ap->in[I_WDND]; J.K = DFF; J.Nsrc = D; J.Ndst = D; J.ldd = DFF; J.WT = Wb + WO_DND; return true; }
    if (j < 26) { const int e = j - 18; J.W = ap->in[I_WGUM] + (size_t)e * D * 2 * DFFE; J.K = D; J.Nsrc = 2 * DFFE; J.Ndst = 2 * DFFE; J.ldd = D; J.map = 2; J.dff = DFFE; J.WT = Wb + WO_GUM + (size_t)e * 2 * DFFE * D; return true; }
    if (j < 34) { const int e = j - 26; J.W = ap->in[I_WDNM] + (size_t)e * DFFE * D; J.K = DFFE; J.Nsrc = D; J.Ndst = D; J.ldd = DFFE; J.WT = Wb + WO_DNM + (size_t)e * D * DFFE; return true; }
    return false;
}

typedef const __attribute__((address_space(4))) Args* KArgs;
#define KA() ({ KArgs _p = (KArgs)__builtin_amdgcn_kernarg_segment_ptr(); asm volatile("" : "+s"(_p)); _p; })
#define PHASE_VARS \
    KArgs A = KA(); unsigned char* const ws = A->ws; (void)ws; \
    int tid = threadIdx.x; asm volatile("" : "+v"(tid)); \
    const int lane = tid & 63, wave = __builtin_amdgcn_readfirstlane(tid >> 6); \
    int G = gridDim.x, bx = blockIdx.x; asm volatile("" : "+s"(G), "+s"(bx)); \
    const int vcu = (G % 8 == 0) ? (bx % 8) * (G / 8) + bx / 8 : bx; \
    const int gw = vcu * NWAVES + wave, ngw = G * NWAVES; \
    const int gtid = vcu * NTHR + tid, gthreads = G * NTHR; \
    (void)lane; (void)wave; (void)gw; (void)ngw; (void)gtid; (void)gthreads; (void)vcu;
#define WSP(T_, off) ((T_*)(ws + (off)))
#define XS ((bf16_t*)A->out)
#define LDXS (2 * D)

__global__ void __launch_bounds__(NTHR, 2) mega_fwd(Args args_unused) {
    extern __shared__ __attribute__((aligned(16))) unsigned char lds_raw[];
    LAS unsigned char* lds = (LAS unsigned char*)lds_raw;
    for (int u = threadIdx.x; u < (LDS_BYTES - LDSCTL_OFF) / 4; u += NTHR) ((LAS unsigned*)(lds + LDSCTL_OFF))[u] = 0u;
    __syncthreads();
#if MK_ONE_LAUNCH
    XcdBarrier bar;
    { KArgs A0 = KA(); bar = xcd_barrier_post((unsigned*)(A0->ws + WS_CTL) + CW_BAR, (volatile LAS unsigned*)(lds + MISC_OFF) + 8); }
#define GRID_BAR() xcd_barrier(bar)
#else
#define GRID_BAR() do { } while (0)
#endif
#if MK_ONE_LAUNCH
    constexpr int lo = 0, hi = N_PHASES;
#else
    int lo, hi; { KArgs A0 = KA(); lo = A0->ph_lo; hi = A0->ph_hi; }
#endif
#define IN(k) (lo <= (k) && (k) < hi)
#define SEAM(k) do { if (IN(k) && (k) + 1 < hi) GRID_BAR(); } while (0)

    if (EN(0) && IN(0)) {
        PHASE_VARS
        LAS float* scr = (LAS float*)(lds + wave * 16384);
        bf16_t* Wb = WSP(bf16_t, WS_W);
        for (int rep = 0; rep < NREP(2); ++rep) {
        int base = 0;
        for (int j = 0; j < 34; ++j) { CvtJob J; get_cvt_job(A, Wb, j, J);
            const int nitems = (J.K / 64) * (J.Ndst / 32);
            int first = (gw - base) % ngw; if (first < 0) first += ngw;
            for (int it = first; it < nitems; it += ngw) cvt_item(J, scr, it, lane);
            base += nitems; }
        }
        for (int l = 0; l < DEPTH; ++l)
            norm_rows<0, false>(A->in[I_MEM], D, A->in[I_NMEM] + l * D, WSP(bf16_t, WS_MEMN) + (size_t)l * TM * D, TM, nullptr, 0, nullptr, gw, ngw, lane);
    }
    SEAM(0);

    for (int l = 0; l < DEPTH; ++l) {
        const int P = 1 + 16 * l;
        if (EN(1) && IN(P + 0)) {
            PHASE_VARS
            for (int rep = 0; rep < NREP(3); ++rep)
              if (l == 0) norm_rows<4, false>(A->in[I_X], D, A->in[I_NMIX] + l * D, WSP(bf16_t, WS_XN), T, A->in[I_WIN] + (size_t)l * D * NIN + 1472, NIN, WSP(float, WS_WI), gw, ngw, lane);
              else norm_rows<4, true>(XS, LDXS, A->in[I_NMIX] + l * D, WSP(bf16_t, WS_XN), T, A->in[I_WIN] + (size_t)l * D * NIN + 1472, NIN, WSP(float, WS_WI), gw, ngw, lane);
        }
        SEAM(P + 0);
        if (IN(P + 1)) {
            if (EN(2)) { PHASE_VARS
              pg8::SchedG1 S; S.init(WSP(bf16_t, WS_XN), WSP(bf16_t, WS_W) + WO_IN + (size_t)l * NINP * D, G, bx);
              pg8::EpiG1 E{WSP(bf16_t, WS_QKV), WSP(bf16_t, WS_GATES), A->in[I_BGATE] + l * NGATE, A->in[I_QNDSA] + l * 64, A->in[I_KNDSA] + l * 64, A->in[I_QNSWA] + l * 64, A->in[I_KNSWA] + l * 64};
              for (int rep = 0; rep < NREP(4); ++rep) pg8::gemm_phase<pg8::EpiG1, pg8::SchedG1>(lds, S, E, D, D); }
            if (EN(3) && l == 0) { PHASE_VARS
              pg8::SchedMemKV S; S.G = G; S.c = (bx + G / 2) % G; S.A = (const char*)WSP(bf16_t, WS_MEMN); S.B0 = (const char*)(WSP(bf16_t, WS_W) + WO_XKV); S.B1 = (const char*)(WSP(bf16_t, WS_W) + WO_XKV + (size_t)D * D);
              pg8::EpiBf16 E{WSP(bf16_t, WS_MEMKV), D};
              pg8::gemm_phase<pg8::EpiBf16, pg8::SchedMemKV>(lds, S, E, D, D); }
        }
        SEAM(P + 1);
        if (IN(P + 2)) {
            { PHASE_VARS
              LAS float* brel = (LAS float*)(lds + 148480);
              for (int i = tid; i < 128 * 12; i += NTHR) { const int rel = i / 12, c = i % 12; brel[i] = A->in[I_RELB][t5_bucket(rel) * 12 + c]; }
              __syncthreads();
              if (EN(4) && l == 0) memk_norm(WSP(bf16_t, WS_MEMKV), A->in[I_KNX], gw, ngw, lane); }
            if (EN(7)) { PHASE_VARS
              bf16_t* QKV = WSP(bf16_t, WS_QKV);
              for (int rep = 0; rep < NREP(12); ++rep) dsa_mfma(QKV + (size_t)T * 768, QKV + (size_t)T * 1024, QKV + (size_t)T * 1088, QKV + (size_t)T * 1152, QKV + (size_t)T * 1408, WSP(float, WS_WI), (LAS float*)(lds + 148480), WSP(bf16_t, WS_O), lds, vcu, G, tid);
              __syncthreads(); }
            if (EN(6)) { PHASE_VARS
              bf16_t* QKV = WSP(bf16_t, WS_QKV);
              for (int rep = 0; rep < NREP(10); ++rep) { swa_mfma(QKV + (size_t)T * 1472, QKV + (size_t)T * 1984, QKV + (size_t)T * 2112, A->in[I_SINKS] + l * 8, (LAS float*)(lds + 148480), WSP(bf16_t, WS_O), lds, vcu, G, tid); __syncthreads(); } }
            if (EN(5)) { PHASE_VARS
              bf16_t* QKV = WSP(bf16_t, WS_QKV);
              for (int rep = 0; rep < NREP(11); ++rep) sb_mfma(QKV, QKV + (size_t)T * 256, QKV + (size_t)T * 512, WSP(bf16_t, WS_O), lds + 65536 + wave * 6144, gw, ngw, lane);
              __syncthreads(); }
        }
        SEAM(P + 2);
        if (EN(8) && IN(P + 3)) {
            PHASE_VARS
            pg8::SchedPlain S; S.init(WSP(bf16_t, WS_O), WSP(bf16_t, WS_W) + WO_P + (size_t)l * D * D, T, D, D, D, D, G, bx);
            pg8::EpiMerge E{WSP(bf16_t, WS_GATES), WSP(bf16_t, WS_MB)};
            for (int rep = 0; rep < NREP(8); ++rep) pg8::gemm_phase<pg8::EpiMerge, pg8::SchedPlain>(lds, S, E, D, D);
        }
        SEAM(P + 3);
        if (EN(9) && IN(P + 4)) {
            PHASE_VARS
            pg8::SchedPlain S; S.init(WSP(bf16_t, WS_MB), WSP(bf16_t, WS_W) + WO_OUT + (size_t)l * D * D, T, D, D, D, D, G, bx);
            pg8::EpiResidB E{(l == 0) ? (const void*)A->in[I_X] : (const void*)XS, (l == 0) ? D : LDXS, (l == 0) ? 1 : 0, XS, LDXS};
            pg8::gemm_phase<pg8::EpiResidB, pg8::SchedPlain>(lds, S, E, D, D);
        }
        SEAM(P + 4);
        if (EN(10) && IN(P + 5)) {
            PHASE_VARS
            for (int rep = 0; rep < NREP(3); ++rep) norm_rows<0, true>(XS, LDXS, A->in[I_NX] + l * D, WSP(bf16_t, WS_XN), T, nullptr, 0, nullptr, gw, ngw, lane);
        }
        SEAM(P + 5);
        if (EN(11) && IN(P + 6)) {
            PHASE_VARS
            pg8::SchedPlain S; S.init(WSP(bf16_t, WS_XN), WSP(bf16_t, WS_W) + WO_XQ + (size_t)l * 512 * D, T, 512, D, D, D, G, bx);
            pg8::EpiBf16 E{WSP(bf16_t, WS_QX), 512};
            pg8::gemm_phase<pg8::EpiBf16, pg8::SchedPlain>(lds, S, E, D, D);
        }
        SEAM(P + 6);
        if (EN(12) && IN(P + 7)) {
            PHASE_VARS
#if USE_X_MFMA
            for (int rep = 0; rep < NREP(1); ++rep)
            xattn_mfma(WSP(bf16_t, WS_QX), WSP(bf16_t, WS_MEMKV) + (size_t)l * TM * D, A->in[I_QNX] + l * 128, WSP(bf16_t, WS_OX), lds, vcu, G, tid);
            __syncthreads();
#else
            xattn_naive(WSP(bf16_t, WS_QX), WSP(bf16_t, WS_MEMKV) + (size_t)l * TM * D, A->in[I_QNX] + l * 128, WSP(bf16_t, WS_OX), gw, ngw, lane);
#endif
        }
        SEAM(P + 7);
        if (EN(13) && IN(P + 8)) {
            PHASE_VARS
            pg8::SchedPlain S; S.init(WSP(bf16_t, WS_OX), WSP(bf16_t, WS_W) + WO_XO + (size_t)l * D * 512, T, D, 512, 512, 512, G, bx);
            pg8::EpiResidB E{XS, LDXS, 0, XS, LDXS};
            pg8::gemm_phase<pg8::EpiResidB, pg8::SchedPlain>(lds, S, E, 512, 512);
        }
        SEAM(P + 8);
        if (l == 0) {
            if (EN(14) && IN(P + 9)) { PHASE_VARS
                for (int rep = 0; rep < NREP(3); ++rep) norm_rows<0, true>(XS, LDXS, A->in[I_NFFN] + l * D, WSP(bf16_t, WS_XN), T, nullptr, 0, nullptr, gw, ngw, lane); }
            SEAM(P + 9);
            if (EN(15) && IN(P + 10)) {
                PHASE_VARS
                pg8::SchedPlain S; S.init(WSP(bf16_t, WS_XN), WSP(bf16_t, WS_W) + WO_GUD, T, 2 * DFF, D, D, D, G, bx);
                pg8::EpiSwiglu E{WSP(bf16_t, WS_ACTD), DFF};
                for (int rep = 0; rep < NREP(7); ++rep) pg8::gemm_phase<pg8::EpiSwiglu, pg8::SchedPlain>(lds, S, E, D, D);
            }
            SEAM(P + 10);
            if (EN(16) && IN(P + 11)) {
                PHASE_VARS
                pg8::SchedPlain S; S.init(WSP(bf16_t, WS_ACTD), WSP(bf16_t, WS_W) + WO_DND, T, D, DFF, DFF, DFF, G, bx);
                pg8::EpiResidB E{XS, LDXS, 0, XS, LDXS};
                pg8::gemm_phase<pg8::EpiResidB, pg8::SchedPlain>(lds, S, E, DFF, DFF);
            }
            if (IN(P + 11) && P + 16 < hi) GRID_BAR();
        } else {
            if (EN(17) && IN(P + 9)) { PHASE_VARS
                norm_router(XS, LDXS, A->in[I_NFFN] + l * D, WSP(bf16_t, WS_XN), A->in[I_WR], WSP(int, WS_TOKE), WSP(float, WS_TOKG), WSP(int, WS_CNT), (LAS int*)(lds + 1024), vcu, G, wave, lane); }
            SEAM(P + 9);
            if (EN(18) && IN(P + 10)) { PHASE_VARS
                moe_assign(WSP(int, WS_CNT), WSP(int, WS_TOKE), WSP(float, WS_TOKG), WSP(int, WS_TOKS), WSP(int, WS_STOK), WSP(float, WS_SGATE), WSP(int, WS_PBASE), WSP(bf16_t, WS_XN), WSP(bf16_t, WS_AG), (LAS int*)(lds + 1024), vcu, G, wave, lane); }
            SEAM(P + 10);
            if (EN(19) && IN(P + 11)) {
                PHASE_VARS
                pg8::SchedMoe S; S.init(WSP(bf16_t, WS_AG), WSP(bf16_t, WS_W) + WO_GUM, WSP(int, WS_PBASE), 2 * DFFE, D, G, bx);
                pg8::EpiSwiglu E{WSP(bf16_t, WS_ACTM), DFFE};
                for (int rep = 0; rep < NREP(5); ++rep) pg8::gemm_phase<pg8::EpiSwiglu, pg8::SchedMoe>(lds, S, E, D, D);
            }
            SEAM(P + 11);
            if (EN(20) && IN(P + 12)) {
                PHASE_VARS
                pg8::SchedMoe S; S.init(WSP(bf16_t, WS_ACTM), WSP(bf16_t, WS_W) + WO_DNM, WSP(int, WS_PBASE), D, DFFE, G, bx);
                pg8::EpiMoeDown E{WSP(bf16_t, WS_Y), WSP(float, WS_SGATE)};
                for (int rep = 0; rep < NREP(6); ++rep) pg8::gemm_phase<pg8::EpiMoeDown, pg8::SchedMoe>(lds, S, E, DFFE, DFFE);
            }
            SEAM(P + 12);
            if (EN(21) && IN(P + 13)) { PHASE_VARS
                moe_combine(A->out, XS, LDXS, WSP(bf16_t, WS_Y), WSP(int, WS_TOKS), gw, ngw, lane); }
        }
    }
#undef IN
#undef SEAM
}


#ifndef DBG_CHECK
#define DBG_CHECK 0
#endif
#if DBG_CHECK
__global__ void dbg_diff(const bf16_t* a, const bf16_t* b, int rows, int ld, int c0, int nc, double* acc, int slot) {
    double d = 0, e = 0;
    for (long i = (long)blockIdx.x * blockDim.x + threadIdx.x; i < (long)rows * nc; i += (long)gridDim.x * blockDim.x) { const long r = i / nc, c = c0 + i % nc; const float x = bf2f(a[r * ld + c]), y = bf2f(b[r * ld + c]); d += (double)(x - y) * (x - y); e += (double)x * x; }
    for (int o = 32; o >= 1; o >>= 1) { d += __shfl_xor(d, o); e += __shfl_xor(e, o); }
    if ((threadIdx.x & 63) == 0) { atomicAdd(acc + 2 * slot, d); atomicAdd(acc + 2 * slot + 1, e); }
}
__global__ void dbg_emit(float* out, const double* acc, int nslots) { double mx = 0; for (int s = 0; s < nslots; ++s) { const double r = acc[2 * s + 1] > 0 ? acc[2 * s] / acc[2 * s + 1] : 1.0; mx = r > mx ? r : mx; } out[0] += (float)(1e8 * mx); }
__global__ void __launch_bounds__(NTHR, 2) dbg_attn(Args args_unused) {
    extern __shared__ __attribute__((aligned(16))) unsigned char lds_raw[];
    LAS unsigned char* lds = (LAS unsigned char*)lds_raw;
    PHASE_VARS
    const int mode = A->ph_lo, l = A->ph_hi;
    bf16_t* QKV = WSP(bf16_t, WS_QKV); bf16_t* OB2 = WSP(bf16_t, WS_MB);
    if (mode == 0) { xattn_mfma(WSP(bf16_t, WS_QX), WSP(bf16_t, WS_MEMKV) + (size_t)l * TM * D, A->in[I_QNX] + l * 128, WSP(bf16_t, WS_OX) + (size_t)T * 512, lds, vcu, G, tid); }
    else {
        LAS float* brel = (LAS float*)(lds + 148480);
        for (int i = tid; i < 128 * 12; i += NTHR) { const int rel = i / 12, c = i % 12; brel[i] = A->in[I_RELB][t5_bucket(rel) * 12 + c]; }
        __syncthreads();
        if (mode == 1) swa_mfma(QKV + (size_t)T * 1472, QKV + (size_t)T * 1984, QKV + (size_t)T * 2112, A->in[I_SINKS] + l * 8, brel, OB2, lds, vcu, G, tid);
        else sb_mfma(QKV, QKV + (size_t)T * 256, QKV + (size_t)T * 512, OB2, lds + 65536 + wave * 6144, gw, ngw, lane);
    }
}
#endif
extern "C" void kernel_launch(void* const* d_in, const int* in_sizes, int n_in, void* d_out, int out_size, void* d_ws, size_t ws_size, hipStream_t stream) {
    static int grid = 0;
    if (grid == 0) {
        if (n_in != N_INPUTS || out_size != T * D || ws_size < WS_END) { fprintf(stderr, "kernel_launch: unexpected problem (n_in %d, out %d, ws %zu)\n", n_in, out_size, ws_size); grid = -1; return; }
        int dev = 0, cus = 0, per_cu = 0;
        if (hipGetDevice(&dev) != hipSuccess || hipDeviceGetAttribute(&cus, hipDeviceAttributeMultiprocessorCount, dev) != hipSuccess) { grid = -1; return; }
        if (hipFuncSetAttribute((const void*)mega_fwd, hipFuncAttributeMaxDynamicSharedMemorySize, LDS_BYTES) != hipSuccess) { fprintf(stderr, "kernel_launch: hipFuncSetAttribute failed\n"); grid = -1; return; }
        if (hipOccupancyMaxActiveBlocksPerMultiprocessor(&per_cu, (const void*)mega_fwd, NTHR, LDS_BYTES) != hipSuccess || per_cu < 1) fprintf(stderr, "kernel_launch: occupancy query says %d\n", per_cu);
        (void)hipGetLastError();
        grid = cus;
    }
    if (grid < 0) return;
    (void)hipMemsetAsync((char*)d_ws + WS_CTL, 0, CTL_ZERO_BYTES, stream);
    Args a{};
    for (int i = 0; i < N_INPUTS; ++i) a.in[i] = (const float*)d_in[i];
    a.out = (float*)d_out; a.ws = (unsigned char*)d_ws; a.pad0 = 0; a.pad1 = 0;
#if MK_ONE_LAUNCH
    a.ph_lo = 0; a.ph_hi = N_PHASES;
    hipLaunchKernelGGL(mega_fwd, dim3(grid), dim3(NTHR), LDS_BYTES, stream, a);
#else
    for (int p = 0; p < N_PHASES; ++p) {
        const int l = (p - 1) / 16, k = (p - 1) % 16;
        if (p > 0) { if (l == 0 && k > 11) continue; if (l == 1 && k > 13) continue; }
        a.ph_lo = p; a.ph_hi = p + 1;
        hipLaunchKernelGGL(mega_fwd, dim3(grid), dim3(NTHR), LDS_BYTES, stream, a);
#if DBG_CHECK
        { static bool attr2 = false; if (!attr2) { (void)hipFuncSetAttribute((const void*)dbg_attn, hipFuncAttributeMaxDynamicSharedMemorySize, LDS_BYTES); attr2 = true; }
          double* acc = (double*)((char*)d_ws + WS_CTL + 512 * 1024);
          if (p > 0 && k == 2) {
              Args a2 = a; a2.ph_hi = l;
              a2.ph_lo = 1; hipLaunchKernelGGL(dbg_attn, dim3(grid), dim3(NTHR), LDS_BYTES, stream, a2);
              hipLaunchKernelGGL(dbg_diff, dim3(1024), dim3(256), 0, stream, (const bf16_t*)((char*)d_ws + WS_O), (const bf16_t*)((char*)d_ws + WS_MB), T, D, 512, 512, acc, 3 * l + 0);
              a2.ph_lo = 2; hipLaunchKernelGGL(dbg_attn, dim3(grid), dim3(NTHR), LDS_BYTES, stream, a2);
              hipLaunchKernelGGL(dbg_diff, dim3(1024), dim3(256), 0, stream, (const bf16_t*)((char*)d_ws + WS_O), (const bf16_t*)((char*)d_ws + WS_MB), T, D, 0, 256, acc, 3 * l + 1); }
          if (p > 0 && k == 7) { Args a2 = a; a2.ph_hi = l; a2.ph_lo = 0; hipLaunchKernelGGL(dbg_attn, dim3(grid), dim3(NTHR), LDS_BYTES, stream, a2);
              hipLaunchKernelGGL(dbg_diff, dim3(1024), dim3(256), 0, stream, (const bf16_t*)((char*)d_ws + WS_OX), (const bf16_t*)((char*)d_ws + WS_OX) + (size_t)T * 512, T, 512, 0, 512, acc, 3 * l + 2); }
          if (p == N_PHASES - 3) hipLaunchKernelGGL(dbg_emit, dim3(1), dim3(1), 0, stream, (float*)d_out, (const double*)acc, DBG_NSLOT); }
#endif
    }
#endif
}
```

```cpp
#include <hip/hip_runtime.h>
#include <cstdio>
#include <cstdint>

#define LAS __attribute__((address_space(3)))
#define GAS __attribute__((address_space(1)))
typedef unsigned short bf16_t;
typedef short bf16x8 __attribute__((ext_vector_type(8)));
typedef float f32x4 __attribute__((ext_vector_type(4)));
typedef float f32x2 __attribute__((ext_vector_type(2)));
typedef unsigned u32x4 __attribute__((ext_vector_type(4)));
typedef unsigned u32x2 __attribute__((ext_vector_type(2)));

constexpr int D = 1024, BATCH = 16, SEQ = 2048, T = BATCH * SEQ, DEPTH = 2;
constexpr int NIN = 5316, NINP = 5376, NHEADC = 2304, NGATE = 3072;
constexpr int DFF = 2816, NEXP = 8, DFFE = 3584, NMEM = 256, TM = BATCH * NMEM;
constexpr int MAXSLOT = 67584;
constexpr float EPS = 1e-6f;

__device__ __forceinline__ unsigned f2bf(float f) { unsigned u = __builtin_bit_cast(unsigned, f); return (u + 0x7fffu + ((u >> 16) & 1u)) >> 16; }
__device__ __forceinline__ unsigned pk2(float lo, float hi) { return f2bf(lo) | (f2bf(hi) << 16); }
__device__ __forceinline__ float bf2f(unsigned short b) { return __builtin_bit_cast(float, ((unsigned)b) << 16); }
__device__ __forceinline__ float bflo(unsigned w) { return __builtin_bit_cast(float, w << 16); }
__device__ __forceinline__ float bfhi(unsigned w) { return __builtin_bit_cast(float, w & 0xffff0000u); }
typedef __bf16 bf16x2_t __attribute__((ext_vector_type(2)));
__device__ __forceinline__ unsigned cvt_pk_bf16(float lo, float hi) { const f32x2 v = {lo, hi}; const bf16x2_t b = __builtin_convertvector(v, bf16x2_t); return __builtin_bit_cast(unsigned, b); }

__device__ __forceinline__ float shx(float v, int o, int lane) { return __builtin_bit_cast(float, __builtin_amdgcn_ds_bpermute((lane ^ o) << 2, __builtin_bit_cast(int, v))); }
__device__ __forceinline__ int shdi(int v, int o, int lane) { return __builtin_amdgcn_ds_bpermute((lane + o) << 2, v); }

namespace pg8 {
constexpr int BM = 256, BK = 64, HALF = 128, HTB = HALF * BK * 2, STAGE_BYTES = 8 * HTB, NXCD = 8, WGM = 8;
__host__ __device__ __forceinline__ int lds_byte(int r, int c) { const int st = (r >> 4) * 2 + (c >> 5), rr = r & 15, cc = c & 31, ob = rr * 64 + cc * 2; return st * 1024 + (ob ^ (((ob >> 9) & 1) << 5)); }
__host__ __device__ __forceinline__ void stage_rc(int b, int& R, int& C) { const int st = b / 1024, sb = b % 1024, swz = sb ^ (((sb >> 9) & 1) << 5); R = (st >> 1) * 16 + swz / 64; C = (st & 1) * 32 + (swz % 64) / 2; }
__host__ __device__ __forceinline__ int perm32(int rho) { const int n = rho >> 4, i = rho & 15; return 8 * (i >> 2) + 4 * n + (i & 3); }

struct Unit { int pm, pn, g, s; };

struct TileOrder {
    int nM, nN, nwg;
    __device__ __forceinline__ void init(int nM_, int nN_) { nM = nM_; nN = nN_; nwg = nM * nN; }
    __device__ __forceinline__ bool get(long L, int& pm, int& pn) const {
        if (L >= nwg) return false;
        int wgid = (int)L; { const int q = nwg / NXCD, r = nwg % NXCD, xcd = wgid % NXCD, off = wgid / NXCD; wgid = (xcd < r ? xcd * (q + 1) : r * (q + 1) + (xcd - r) * q) + off; }
        const int nig = WGM * nN, gid = wgid / nig, fm = gid * WGM, gsz = (nM - fm) < WGM ? (nM - fm) : WGM;
        pm = fm + ((wgid % nig) % gsz); pn = (wgid % nig) / gsz; return true;
    }
};

template <class Epi, class Sched>
__device__ __forceinline__ void gemm_phase(LAS unsigned char* lds, const Sched& S, const Epi& E, const int lda, const int ldb) {
    int tid = threadIdx.x; asm volatile("" : "+v"(tid));
    const int wid = __builtin_amdgcn_readfirstlane(tid >> 6), lane = tid & 63, wr = wid >> 2, wc = wid & 3, fr = lane & 15, fq = lane >> 4;
    unsigned voffA[2], voffB[2];
#pragma unroll
    for (int i = 0; i < 2; ++i) { int R, C; stage_rc(tid * 16 + i * 8192, R, C); const int Rb = Epi::PERM ? ((R & ~31) + perm32(R & 31)) : R;
        voffA[i] = (unsigned)(R * lda + C) * 2u; voffB[i] = (unsigned)(Rb * ldb + C) * 2u; }
    const size_t kstep = (size_t)(BK * 2);
    const size_t hstepA = (size_t)HALF * lda * 2, hstepB = (size_t)HALF * ldb * 2;
    const unsigned ldsw = (unsigned)wid * 1024u;
    const int aoff = lds_byte(wr * 64 + fr, fq * 8), boff = lds_byte(wc * 32 + fr, fq * 8);
#define PG8_SA(b, h) (((b) * 2 + (h)) * HTB)
#define PG8_SB(b, h) ((4 + (b) * 2 + (h)) * HTB)
#define PG8_STAGE(bufoff, gbase, voff) do { _Pragma("unroll") for (int _i = 0; _i < 2; ++_i) \
        __builtin_amdgcn_global_load_lds((const unsigned*)((const char*)(gbase) + (voff)[_i]), (LAS unsigned*)(lds + (bufoff) + ldsw + _i * 8192), 16, 0, 0); } while (0)
#define PG8_LDA(dst, b, h) do { _Pragma("unroll") for (int m = 0; m < 4; ++m) _Pragma("unroll") for (int k = 0; k < 2; ++k) dst[m][k] = *(const LAS bf16x8*)(lds + PG8_SA(b, h) + aoff + m * 2048 + k * 1024); } while (0)
#define PG8_LDB(dst, b, h) do { _Pragma("unroll") for (int n = 0; n < 2; ++n) _Pragma("unroll") for (int k = 0; k < 2; ++k) dst[n][k] = *(const LAS bf16x8*)(lds + PG8_SB(b, h) + boff + n * 2048 + k * 1024); } while (0)
#define PG8_MMA(ai, bj, At, Bt) do { __builtin_amdgcn_s_setprio(1); _Pragma("unroll") for (int m = 0; m < 4; ++m) _Pragma("unroll") for (int n = 0; n < 2; ++n) _Pragma("unroll") for (int k = 0; k < 2; ++k) \
        acc[ai][bj][m][n] = __builtin_amdgcn_mfma_f32_16x16x32_bf16(Bt[n][k], At[m][k], acc[ai][bj][m][n], 0, 0, 0); __builtin_amdgcn_s_setprio(0); } while (0)
#define PG8_WAIT_V(n) asm volatile("s_waitcnt vmcnt(" #n ")" ::: "memory")
#define PG8_WAIT_L(n) asm volatile("s_waitcnt lgkmcnt(" #n ")" ::: "memory")
#define PG8_BAR __builtin_amdgcn_s_barrier()
#define PG8_SCHED __builtin_amdgcn_sched_barrier(0)
    Unit cur, nxt; int ui = 0;
    if (!S.next(0, cur)) return;
    f32x4 acc[2][2][4][2];
#pragma unroll
    for (int a = 0; a < 2; ++a)
#pragma unroll
        for (int b = 0; b < 2; ++b)
#pragma unroll
            for (int m = 0; m < 4; ++m)
#pragma unroll
                for (int n = 0; n < 2; ++n) acc[a][b][m][n] = (f32x4){0.f, 0.f, 0.f, 0.f};
    bf16x8 At[4][2], B0[2][2], B1[2][2];
    const char* cA = S.a_ptr(cur); const char* cB = S.b_ptr(cur); int nt = S.nt(cur);
    int rot = 0; if constexpr (Sched::ROT) rot = cur.g;
    { const char* fA = cA + (size_t)rot * kstep; const char* fB = cB + (size_t)rot * kstep;
      PG8_STAGE(PG8_SB(0, 0), fB, voffB); PG8_STAGE(PG8_SB(0, 1), fB + hstepB, voffB); PG8_STAGE(PG8_SA(0, 0), fA, voffA); PG8_STAGE(PG8_SA(0, 1), fA + hstepA, voffA);
      if (wr == 1) PG8_BAR;
      PG8_WAIT_V(2); PG8_BAR;
      PG8_STAGE(PG8_SB(1, 0), fB + kstep, voffB); PG8_STAGE(PG8_SA(1, 0), fA + kstep, voffA); PG8_STAGE(PG8_SB(1, 1), fB + hstepB + kstep, voffB);
      PG8_WAIT_V(6); PG8_BAR; }
    for (;;) {
        const bool has_next = S.next(ui + 1, nxt);
        const char* nA = cA; const char* nB = cB; int nnt = nt, nrot = rot;
        if (has_next) { nA = S.a_ptr(nxt); nB = S.b_ptr(nxt); nnt = S.nt(nxt); if constexpr (Sched::ROT) nrot = nxt.g; }
        nA += (size_t)nrot * kstep; nB += (size_t)nrot * kstep;
        for (int t = 0; t < nt; t += 2) {
            if constexpr (Epi::HOOK) { if (E.hook_at(cur, t)) E.mid(acc, cur, t, wr, wc, fr, fq); }
            const bool last = (t == nt - 2);
            const int k0 = Sched::ROT ? ((t + rot) & (nt - 1)) : t, k2 = Sched::ROT ? ((t + 2 + rot) & (nt - 1)) : t + 2;
            const char* a1 = cA + (size_t)(k0 + 1) * kstep;
            const char* a2 = last ? nA : cA + (size_t)k2 * kstep; const char* b2 = last ? nB : cB + (size_t)k2 * kstep;
            const char* a3 = a2 + kstep; const char* b3 = b2 + kstep;
            PG8_LDB(B0, 0, 0); PG8_LDB(B1, 0, 1); PG8_SCHED; PG8_LDA(At, 0, 0); PG8_STAGE(PG8_SA(1, 1), a1 + hstepA, voffA);
            PG8_WAIT_V(8); PG8_WAIT_L(0); PG8_BAR; PG8_MMA(0, 0, At, B0); PG8_MMA(0, 1, At, B1); PG8_BAR; PG8_SCHED;
            PG8_LDA(At, 0, 1); PG8_STAGE(PG8_SB(0, 0), b2, voffB); PG8_STAGE(PG8_SB(0, 1), b2 + hstepB, voffB); PG8_STAGE(PG8_SA(0, 0), a2, voffA);
            PG8_WAIT_V(8); PG8_WAIT_L(0); PG8_BAR; PG8_MMA(1, 0, At, B0); PG8_MMA(1, 1, At, B1); PG8_BAR; PG8_SCHED;
            PG8_LDB(B0, 1, 0); PG8_LDB(B1, 1, 1); PG8_SCHED; PG8_LDA(At, 1, 0); PG8_STAGE(PG8_SA(0, 1), a2 + hstepA, voffA);
            PG8_WAIT_V(8); PG8_WAIT_L(0); PG8_BAR; PG8_MMA(0, 0, At, B0); PG8_MMA(0, 1, At, B1); PG8_BAR; PG8_SCHED;
            PG8_LDA(At, 1, 1); PG8_STAGE(PG8_SB(1, 0), b3, voffB); PG8_STAGE(PG8_SB(1, 1), b3 + hstepB, voffB); PG8_STAGE(PG8_SA(1, 0), a3, voffA);
            PG8_WAIT_V(8); PG8_WAIT_L(0); PG8_BAR; PG8_MMA(1, 0, At, B0); PG8_MMA(1, 1, At, B1); PG8_BAR; PG8_SCHED;
        }
        if (wr == 0) PG8_BAR;
        E(acc, cur, wr, wc, fr, fq);
        if (!has_next) break;
#pragma unroll
        for (int a = 0; a < 2; ++a)
#pragma unroll
            for (int b = 0; b < 2; ++b)
#pragma unroll
                for (int m = 0; m < 4; ++m)
#pragma unroll
                    for (int n = 0; n < 2; ++n) acc[a][b][m][n] = (f32x4){0.f, 0.f, 0.f, 0.f};
        cur = nxt; cA = nA - (size_t)nrot * kstep; cB = nB - (size_t)nrot * kstep; nt = nnt; rot = nrot; ++ui;
        if (wr == 1) PG8_BAR;
    }
    PG8_WAIT_V(0);
    PG8_BAR;
#undef PG8_SA
#undef PG8_SB
#undef PG8_STAGE
#undef PG8_LDA
#undef PG8_LDB
#undef PG8_MMA
#undef PG8_WAIT_V
#undef PG8_WAIT_L
#undef PG8_BAR
#undef PG8_SCHED
}
}
namespace pg8 {
__device__ __forceinline__ float gate_sigmoid(float x) { float d = 1.0f + __builtin_amdgcn_exp2f(x * -1.4426950408889634f); asm("v_min_f32 %0, 0x5368d4a5, %1" : "=v"(d) : "v"(d)); return __builtin_amdgcn_rcpf(d); }
__device__ __forceinline__ float sigmoidf_(float x) { return __builtin_amdgcn_rcpf(1.0f + __builtin_amdgcn_exp2f(x * -1.4426950408889634f)); }

struct SchedPlain {
    static constexpr bool ROT = false;
    TileOrder to; int G, c, ntk; const char* A; const char* B; size_t astep, bstep;
    __device__ __forceinline__ void init(const void* A_, const void* B_, int M, int N, int K, int lda, int ldb, int G_, int c_) {
        to.init(M / BM, N / BM); G = G_; c = c_; ntk = K / BK; A = (const char*)A_; B = (const char*)B_; astep = (size_t)BM * lda * 2; bstep = (size_t)BM * ldb * 2; }
    __device__ __forceinline__ bool next(int i, Unit& u) const { u.g = 0; return to.get((long)i * G + c, u.pm, u.pn); }
    __device__ __forceinline__ const char* a_ptr(const Unit& u) const { return A + (size_t)u.pm * astep; }
    __device__ __forceinline__ const char* b_ptr(const Unit& u) const { return B + (size_t)u.pn * bstep; }
    __device__ __forceinline__ int nt(const Unit&) const { return ntk; }
};
struct SchedRot : SchedPlain {
    static constexpr bool ROT = true;
    __device__ __forceinline__ bool next(int i, Unit& u) const { u.g = ((c >> 3) & 1) ? 8 : 0; return to.get((long)i * G + c, u.pm, u.pn); }
};
struct SchedG1 {
    static constexpr bool ROT = false;
    TileOrder th, tg; int G, c; const char* A; const char* B;
    __device__ __forceinline__ void init(const void* A_, const void* B_, int G_, int c_) { th.init(T / BM, 9); tg.init(T / BM, 12); G = G_; c = c_; A = (const char*)A_; B = (const char*)B_; }
    __device__ __forceinline__ bool next(int i, Unit& u) const { const long L = (long)i * G + c; u.g = 0;
        if (L < th.nwg) return th.get(L, u.pm, u.pn);
        if (!tg.get(L - th.nwg, u.pm, u.pn)) return false; u.pn += 9; return true; }
    __device__ __forceinline__ const char* a_ptr(const Unit& u) const { return A + (size_t)u.pm * BM * D * 2; }
    __device__ __forceinline__ const char* b_ptr(const Unit& u) const { return B + (size_t)u.pn * BM * D * 2; }
    __device__ __forceinline__ int nt(const Unit&) const { return D / BK; }
};
struct SchedMerge {
    static constexpr bool ROT = false;
    TileOrder to; int G, c; const char* A; const char* B;
    __device__ __forceinline__ void init(const void* A_, const void* B_, int G_, int c_) { to.init(T / BM, D / BM); G = G_; c = c_; A = (const char*)A_; B = (const char*)B_; }
    __device__ __forceinline__ bool next(int i, Unit& u) const { const int ti = i / 3; u.g = i - 3 * ti; return to.get((long)ti * G + c, u.pm, u.pn); }
    __device__ __forceinline__ int koff(int g) const { return g == 0 ? 0 : (g == 1 ? 256 : 512); }
    __device__ __forceinline__ const char* a_ptr(const Unit& u) const { return A + ((size_t)u.pm * BM * D + koff(u.g)) * 2; }
    __device__ __forceinline__ const char* b_ptr(const Unit& u) const { return B + ((size_t)u.pn * BM * D + koff(u.g)) * 2; }
    __device__ __forceinline__ int nt(const Unit& u) const { return u.g == 2 ? 8 : 4; }
};
struct SchedMemKV {
    static constexpr bool ROT = false;
    int G, c; const char* A; const char* B0; const char* B1;
    __device__ __forceinline__ bool next(int i, Unit& u) const { const long L = (long)i * G + c; if (L >= 128) return false; u.pm = (int)L >> 2; u.pn = (int)L & 3; u.g = u.pm >> 4; return true; }
    __device__ __forceinline__ const char* a_ptr(const Unit& u) const { return A + (size_t)u.pm * BM * D * 2; }
    __device__ __forceinline__ const char* b_ptr(const Unit& u) const { return (u.g ? B1 : B0) + (size_t)u.pn * BM * D * 2; }
    __device__ __forceinline__ int nt(const Unit&) const { return D / BK; }
};
struct SchedMoe {
    static constexpr bool ROT = false;
    TileOrder to; int G, c, ntk; const char* A; const char* B; size_t astep, bstep, estep; int pb[NEXP + 1];
    __device__ __forceinline__ void init(const void* A_, const void* B_, const int* pbase, int N, int K, int G_, int c_) {
#pragma unroll
        for (int e = 0; e <= NEXP; ++e) pb[e] = pbase[e];
        to.init(pb[NEXP], N / BM); G = G_; c = c_; ntk = K / BK; A = (const char*)A_; B = (const char*)B_; astep = (size_t)BM * K * 2; bstep = (size_t)BM * K * 2; estep = (size_t)N * K * 2; }
    __device__ __forceinline__ bool next(int i, Unit& u) const { if (!to.get((long)i * G + c, u.pm, u.pn)) return false; int e = 0;
#pragma unroll
        for (int j = 1; j < NEXP; ++j) e += (u.pm >= pb[j]) ? 1 : 0;
        u.g = e; return true; }
    __device__ __forceinline__ const char* a_ptr(const Unit& u) const { return A + (size_t)u.pm * astep; }
    __device__ __forceinline__ const char* b_ptr(const Unit& u) const { return B + (size_t)u.g * estep + (size_t)u.pn * bstep; }
    __device__ __forceinline__ int nt(const Unit&) const { return ntk; }
};

__device__ __forceinline__ void moe_tail_split(int U, int G, int ntk, int& nfull, int& tail, int& S) {
    nfull = U / G; tail = U - nfull * G; S = 1;
    const int cand[4] = {14, 7, 4, 2};
#pragma unroll
    for (int i = 3; i >= 0; --i) { const int s = cand[i]; if (tail > 0 && ntk % s == 0 && ((ntk / s) & 1) == 0 && ntk / s >= 4 && s * tail <= G) S = s; }
}
struct SchedMoeMain : SchedMoe {
    int nfull;
    __device__ __forceinline__ bool next(int i, Unit& u) const { if (i >= nfull) return false; return SchedMoe::next(i, u); }
};
struct SchedMoeTail : SchedMoe {
    int valid, pidx, ntp; long L; size_t koff;
    __device__ __forceinline__ void init_tail(int nfull, int tail, int S) {
        valid = (tail > 0 && c < S * tail) ? 1 : 0; const int tl = tail > 0 ? tail : 1, j = c % tl, s = c / tl;
        pidx = s * tl + j; ntp = ntk / S; L = (long)nfull * G + j; koff = (size_t)s * (size_t)ntp * (size_t)(BK * 2); }
    __device__ __forceinline__ bool next(int i, Unit& u) const { if (i != 0 || !valid) return false; if (!to.get(L, u.pm, u.pn)) return false; int e = 0;
#pragma unroll
        for (int j = 1; j < NEXP; ++j) e += (u.pm >= pb[j]) ? 1 : 0;
        u.g = e; return true; }
    __device__ __forceinline__ const char* a_ptr(const Unit& u) const { return A + (size_t)u.pm * astep + koff; }
    __device__ __forceinline__ const char* b_ptr(const Unit& u) const { return B + (size_t)u.g * estep + (size_t)u.pn * bstep + koff; }
    __device__ __forceinline__ int nt(const Unit&) const { return ntp; }
};

struct EpiResid {
    static constexpr bool PERM = false, HOOK = false;
    const float* base; float* out; int ldc;
    __device__ __forceinline__ void operator()(const f32x4 (&acc)[2][2][4][2], const Unit& u, int wr, int wc, int fr, int fq) const {
        const int row0 = u.pm * BM + wr * 64 + fr, col0 = u.pn * BM + wc * 32 + 4 * fq;
#pragma unroll
        for (int ai = 0; ai < 2; ++ai)
#pragma unroll
            for (int m = 0; m < 4; ++m) { const size_t off = (size_t)(row0 + ai * HALF + m * 16) * ldc + col0;
                f32x4 bs[2][2];
#pragma unroll
                for (int bj = 0; bj < 2; ++bj)
#pragma unroll
                    for (int n = 0; n < 2; ++n) bs[bj][n] = *(const f32x4*)(base + off + bj * HALF + n * 16);
#pragma unroll
                for (int bj = 0; bj < 2; ++bj)
#pragma unroll
                    for (int n = 0; n < 2; ++n) *(f32x4*)(out + off + bj * HALF + n * 16) = bs[bj][n] + acc[ai][bj][m][n];
                asm volatile("" ::: "memory"); }
    }
};
struct EpiResidB {
    static constexpr bool PERM = true, HOOK = false;
    const void* base; int ldb; int base_f32; bf16_t* out; int ldc;
    __device__ __forceinline__ void operator()(const f32x4 (&acc)[2][2][4][2], const Unit& u, int wr, int wc, int fr, int fq) const {
        const int row0 = u.pm * BM + wr * 64 + fr, col0 = u.pn * BM + wc * 32 + 8 * fq;
#pragma unroll
        for (int ai = 0; ai < 2; ++ai)
#pragma unroll
            for (int m = 0; m < 4; ++m) { const int row = row0 + ai * HALF + m * 16;
                f32x4 bs[2][2];
                if (base_f32) {
#pragma unroll
                    for (int bj = 0; bj < 2; ++bj) { const float* bp = (const float*)base + (size_t)row * ldb + col0 + bj * HALF; bs[bj][0] = *(const f32x4*)bp; bs[bj][1] = *(const f32x4*)(bp + 4); }
                } else {
#pragma unroll
                    for (int bj = 0; bj < 2; ++bj) { const u32x4 w = *(const u32x4*)((const bf16_t*)base + (size_t)row * ldb + col0 + bj * HALF);
                        bs[bj][0] = f32x4{bflo(w.x), bfhi(w.x), bflo(w.y), bfhi(w.y)}; bs[bj][1] = f32x4{bflo(w.z), bfhi(w.z), bflo(w.w), bfhi(w.w)}; }
                }
                bf16_t* rowp = out + (size_t)row * ldc + col0;
#pragma unroll
                for (int bj = 0; bj < 2; ++bj) { const f32x4 v0 = acc[ai][bj][m][0] + bs[bj][0], v1 = acc[ai][bj][m][1] + bs[bj][1];
                    u32x4 w; w.x = cvt_pk_bf16(v0[0], v0[1]); w.y = cvt_pk_bf16(v0[2], v0[3]); w.z = cvt_pk_bf16(v1[0], v1[1]); w.w = cvt_pk_bf16(v1[2], v1[3]);
                    *(u32x4*)(rowp + bj * HALF) = w; }
                asm volatile("" ::: "memory"); }
    }
};
struct EpiBf16 {
    static constexpr bool PERM = true, HOOK = false;
    bf16_t* O; int ldc;
    __device__ __forceinline__ void operator()(const f32x4 (&acc)[2][2][4][2], const Unit& u, int wr, int wc, int fr, int fq) const {
        const int row0 = u.pm * BM + wr * 64 + fr, col0 = u.pn * BM + wc * 32 + 8 * fq;
#pragma unroll
        for (int ai = 0; ai < 2; ++ai)
#pragma unroll
            for (int m = 0; m < 4; ++m) { bf16_t* rowp = O + (size_t)(row0 + ai * HALF + m * 16) * ldc + col0;
#pragma unroll
                for (int bj = 0; bj < 2; ++bj) { const f32x4 v0 = acc[ai][bj][m][0], v1 = acc[ai][bj][m][1];
                    u32x4 w; w.x = cvt_pk_bf16(v0[0], v0[1]); w.y = cvt_pk_bf16(v0[2], v0[3]); w.z = cvt_pk_bf16(v1[0], v1[1]); w.w = cvt_pk_bf16(v1[2], v1[3]);
                    *(u32x4*)(rowp + bj * HALF) = w; } }
    }
};
struct EpiG1 {
    static constexpr bool PERM = true, HOOK = false;
    bf16_t* qkv;
    bf16_t* gates;
    const float* bgate;
    const float *gn_qb, *gn_kb, *gn_qc, *gn_kc;
    __device__ __forceinline__ void operator()(const f32x4 (&acc)[2][2][4][2], const Unit& u, int wr, int wc, int fr, int fq) const {
        const int row0 = u.pm * BM + wr * 64 + fr;
        if (u.pn < 9) {
            const int slot = 4 * u.pn + wc;
            if (slot == 35) return;
            size_t dst; int pitch, head; const float* gn = nullptr;
            if (slot < 4)       { dst = 0;                        pitch = 256; head = slot; }
            else if (slot < 8)  { dst = (size_t)T * 256;          pitch = 256; head = slot - 4; }
            else if (slot < 12) { dst = (size_t)T * 512;          pitch = 256; head = slot - 8; }
            else if (slot < 16) { dst = (size_t)T * 768;          pitch = 256; head = slot - 12; gn = gn_qb; }
            else if (slot == 16){ dst = (size_t)T * 1024;         pitch = 64;  head = 0; gn = gn_kb; }
            else if (slot == 17){ dst = (size_t)T * 1088;         pitch = 64;  head = 0; }
            else if (slot < 22) { dst = (size_t)T * 1152;         pitch = 256; head = slot - 18; }
            else if (slot == 22){ dst = (size_t)T * 1408;         pitch = 64;  head = 0; }
            else if (slot < 31) { dst = (size_t)T * 1472;         pitch = 512; head = slot - 23; gn = gn_qc; }
            else if (slot < 33) { dst = (size_t)T * 1984;         pitch = 128; head = slot - 31; gn = gn_kc; }
            else                { dst = (size_t)T * 2112;         pitch = 128; head = slot - 33; }
            bf16_t* base = qkv + dst + head * 64 + 8 * fq;
            f32x4 g0[2], g1[2];
            if (gn) {
#pragma unroll
                for (int bj = 0; bj < 2; ++bj) { g0[bj] = *(const f32x4*)(gn + 32 * bj + 8 * fq); g1[bj] = *(const f32x4*)(gn + 32 * bj + 8 * fq + 4); }
            }
#pragma unroll
            for (int ai = 0; ai < 2; ++ai)
#pragma unroll
                for (int m = 0; m < 4; ++m) {
                    f32x4 v[2][2];
#pragma unroll
                    for (int bj = 0; bj < 2; ++bj) { v[bj][0] = acc[ai][bj][m][0]; v[bj][1] = acc[ai][bj][m][1]; }
                    if (gn) {
                        float ss = 0.f;
#pragma unroll
                        for (int bj = 0; bj < 2; ++bj)
#pragma unroll
                            for (int n = 0; n < 2; ++n) ss += (v[bj][n][0] * v[bj][n][0] + v[bj][n][1] * v[bj][n][1]) + (v[bj][n][2] * v[bj][n][2] + v[bj][n][3] * v[bj][n][3]);
                        ss += shx(ss, 16, 16 * fq + fr); ss += shx(ss, 32, 16 * fq + fr);
                        const float r = __builtin_amdgcn_rsqf(ss * (1.0f / 64.0f) + EPS);
#pragma unroll
                        for (int bj = 0; bj < 2; ++bj) { v[bj][0] = v[bj][0] * r * g0[bj]; v[bj][1] = v[bj][1] * r * g1[bj]; }
                    }
                    bf16_t* rowp = base + (size_t)(row0 + ai * HALF + m * 16) * pitch;
#pragma unroll
                    for (int bj = 0; bj < 2; ++bj) { u32x4 w; w.x = cvt_pk_bf16(v[bj][0][0], v[bj][0][1]); w.y = cvt_pk_bf16(v[bj][0][2], v[bj][0][3]); w.z = cvt_pk_bf16(v[bj][1][0], v[bj][1][1]); w.w = cvt_pk_bf16(v[bj][1][2], v[bj][1][3]);
                        *(u32x4*)(rowp + 32 * bj) = w; }
                }
        } else {
            const int col0 = (u.pn - 9) * BM + wc * 32 + 8 * fq;
            f32x4 bv[2][2];
#pragma unroll
            for (int bj = 0; bj < 2; ++bj)
#pragma unroll
                for (int n = 0; n < 2; ++n) bv[bj][n] = *(const f32x4*)(bgate + col0 + bj * HALF + 4 * n);
#pragma unroll
            for (int ai = 0; ai < 2; ++ai)
#pragma unroll
                for (int m = 0; m < 4; ++m) { bf16_t* rowp = gates + (size_t)(row0 + ai * HALF + m * 16) * NGATE + col0;
#pragma unroll
                    for (int bj = 0; bj < 2; ++bj) { f32x4 v0 = acc[ai][bj][m][0] + bv[bj][0], v1 = acc[ai][bj][m][1] + bv[bj][1];
#pragma unroll
                        for (int j = 0; j < 4; ++j) { v0[j] = gate_sigmoid(v0[j]); v1[j] = gate_sigmoid(v1[j]); }
                        u32x4 w; w.x = cvt_pk_bf16(v0[0], v0[1]); w.y = cvt_pk_bf16(v0[2], v0[3]); w.z = cvt_pk_bf16(v1[0], v1[1]); w.w = cvt_pk_bf16(v1[2], v1[3]);
                        *(u32x4*)(rowp + bj * HALF) = w; } }
        }
    }
};
struct EpiMerge {
    static constexpr bool PERM = true, HOOK = true;
    const bf16_t* gates; bf16_t* mb;
    __device__ __forceinline__ bool hook_at(const Unit& u, int t) const { return u.g == 0 ? (t == 4 || t == 8) : (t == 8 || t == 12); }
    __device__ __forceinline__ void mid(f32x4 (&acc)[2][2][4][2], const Unit& u, int t, int wr, int wc, int fr, int fq) const {
        int row0 = u.pm * BM + wr * 64 + fr; const int col0 = u.pn * BM + wc * 32 + 8 * fq;
        const int ga = (u.g == 0) ? ((t == 4) ? 0 : D) : ((t == 8) ? 2 * D : 0), gb = (u.g == 0) ? ga + D : ((t == 8) ? 0 : D);
        asm volatile("" : "+v"(row0));
        u32x4 na[2][2][2], nb[2][2][2];
#define MERGE_ISSUE(q) do { _Pragma("unroll") for (int mi = 0; mi < 2; ++mi) { const bf16_t* gp = gates + (size_t)(row0 + ((q) >> 1) * HALF + (2 * ((q) & 1) + mi) * 16) * NGATE + col0; \
            _Pragma("unroll") for (int bj = 0; bj < 2; ++bj) { na[(q) & 1][mi][bj] = *(const u32x4*)(gp + ga + bj * HALF); nb[(q) & 1][mi][bj] = *(const u32x4*)(gp + gb + bj * HALF); } } } while (0)
        MERGE_ISSUE(0); MERGE_ISSUE(1);
#pragma unroll
        for (int q = 0; q < 4; ++q) {
            asm volatile("" ::: "memory");
            const int ai = q >> 1;
#pragma unroll
            for (int mi = 0; mi < 2; ++mi) { const int m = 2 * (q & 1) + mi;
#pragma unroll
                for (int bj = 0; bj < 2; ++bj) { const u32x4 wa = na[q & 1][mi][bj], wb = nb[q & 1][mi][bj];
                    const f32x4 a0 = {bflo(wa.x), bfhi(wa.x), bflo(wa.y), bfhi(wa.y)}, a1 = {bflo(wa.z), bfhi(wa.z), bflo(wa.w), bfhi(wa.w)};
                    const f32x4 b0 = {__builtin_amdgcn_rcpf(bflo(wb.x)), __builtin_amdgcn_rcpf(bfhi(wb.x)), __builtin_amdgcn_rcpf(bflo(wb.y)), __builtin_amdgcn_rcpf(bfhi(wb.y))};
                    const f32x4 b1 = {__builtin_amdgcn_rcpf(bflo(wb.z)), __builtin_amdgcn_rcpf(bfhi(wb.z)), __builtin_amdgcn_rcpf(bflo(wb.w)), __builtin_amdgcn_rcpf(bfhi(wb.w))};
                    acc[ai][bj][m][0] *= a0 * b0; acc[ai][bj][m][1] *= a1 * b1; } }
            asm volatile("" ::: "memory");
            if (q == 0) MERGE_ISSUE(2);
            if (q == 1) MERGE_ISSUE(3);
        }
#undef MERGE_ISSUE
    }
    __device__ __forceinline__ void operator()(const f32x4 (&acc)[2][2][4][2], const Unit& u, int wr, int wc, int fr, int fq) const {
        const int row0 = u.pm * BM + wr * 64 + fr, col0 = u.pn * BM + wc * 32 + 8 * fq, gfin = (u.g == 0) ? 2 * D : D;
#pragma unroll
        for (int ai = 0; ai < 2; ++ai)
#pragma unroll
            for (int m = 0; m < 4; ++m) { const size_t row = (size_t)(row0 + ai * HALF + m * 16);
#pragma unroll
                for (int bj = 0; bj < 2; ++bj) { const int col = col0 + bj * HALF;
                    const u32x4 gw = *(const u32x4*)(gates + row * NGATE + gfin + col);
                    f32x4 v0 = acc[ai][bj][m][0], v1 = acc[ai][bj][m][1];
                    v0 *= f32x4{bflo(gw.x), bfhi(gw.x), bflo(gw.y), bfhi(gw.y)}; v1 *= f32x4{bflo(gw.z), bfhi(gw.z), bflo(gw.w), bfhi(gw.w)};
                    u32x4 w; w.x = cvt_pk_bf16(v0[0], v0[1]); w.y = cvt_pk_bf16(v0[2], v0[3]); w.z = cvt_pk_bf16(v1[0], v1[1]); w.w = cvt_pk_bf16(v1[2], v1[3]);
                    *(u32x4*)(mb + row * D + col) = w; } }
    }
};
struct EpiSwiglu {
    static constexpr bool PERM = true, HOOK = false;
    bf16_t* O; int ldc;
    __device__ __forceinline__ void operator()(const f32x4 (&acc)[2][2][4][2], const Unit& u, int wr, int wc, int fr, int fq) const {
        const int row0 = u.pm * BM + wr * 64 + fr, col0 = u.pn * HALF + wc * 32 + 8 * fq;
#pragma unroll
        for (int ai = 0; ai < 2; ++ai)
#pragma unroll
            for (int m = 0; m < 4; ++m) { bf16_t* rowp = O + (size_t)(row0 + ai * HALF + m * 16) * ldc + col0;
                f32x4 r[2];
#pragma unroll
                for (int n = 0; n < 2; ++n) { const f32x4 g = acc[ai][0][m][n], uu = acc[ai][1][m][n];
#pragma unroll
                    for (int j = 0; j < 4; ++j) r[n][j] = g[j] * sigmoidf_(g[j]) * uu[j]; }
                u32x4 w; w.x = cvt_pk_bf16(r[0][0], r[0][1]); w.y = cvt_pk_bf16(r[0][2], r[0][3]); w.z = cvt_pk_bf16(r[1][0], r[1][1]); w.w = cvt_pk_bf16(r[1][2], r[1][3]);
                *(u32x4*)rowp = w; }
    }
};
struct EpiMoeDown {
    static constexpr bool PERM = true, HOOK = false;
    bf16_t* Y; const float* sgate;
    __device__ __forceinline__ void operator()(const f32x4 (&acc)[2][2][4][2], const Unit& u, int wr, int wc, int fr, int fq) const {
        const int row0 = u.pm * BM + wr * 64 + fr, col0 = u.pn * BM + wc * 32 + 8 * fq;
#pragma unroll
        for (int ai = 0; ai < 2; ++ai)
#pragma unroll
            for (int m = 0; m < 4; ++m) { const int row = row0 + ai * HALF + m * 16; const float gt = sgate[row]; bf16_t* rowp = Y + (size_t)row * D + col0;
#pragma unroll
                for (int bj = 0; bj < 2; ++bj) { const f32x4 v0 = acc[ai][bj][m][0] * gt, v1 = acc[ai][bj][m][1] * gt;
                    u32x4 w; w.x = cvt_pk_bf16(v0[0], v0[1]); w.y = cvt_pk_bf16(v0[2], v0[3]); w.z = cvt_pk_bf16(v1[0], v1[1]); w.w = cvt_pk_bf16(v1[2], v1[3]);
                    *(u32x4*)(rowp + bj * HALF) = w; } }
    }
};
struct EpiMoePart {
    static constexpr bool PERM = true, HOOK = false;
    float* part; int* tmap; int pidx, tail;
    __device__ __forceinline__ void operator()(const f32x4 (&acc)[2][2][4][2], const Unit& u, int wr, int wc, int fr, int fq) const {
        float* pt = part + (size_t)pidx * (BM * BM) + (size_t)(wr * 64 + fr) * BM + wc * 32 + 8 * fq;
#pragma unroll
        for (int ai = 0; ai < 2; ++ai)
#pragma unroll
            for (int m = 0; m < 4; ++m)
#pragma unroll
                for (int bj = 0; bj < 2; ++bj) { float* p = pt + (size_t)(ai * HALF + m * 16) * BM + bj * HALF; *(f32x4*)p = acc[ai][bj][m][0]; *(f32x4*)(p + 4) = acc[ai][bj][m][1]; }
        if (pidx < tail && wr == 0 && wc == 0 && fr == 0 && fq == 0) tmap[u.pm * 4 + u.pn] = pidx + 1;
    }
};
}
constexpr size_t MiB = 1u << 20;
constexpr size_t WS_CTL = 0, CTL_ZERO_BYTES = 1 * MiB;
constexpr size_t WS_SMALL = 1 * MiB;
constexpr size_t WS_WI    = WS_SMALL;
constexpr size_t WS_TOKE  = WS_SMALL + 512 * 1024;
constexpr size_t WS_TOKG  = WS_TOKE + 256 * 1024;
constexpr size_t WS_TOKS  = WS_TOKG + 256 * 1024;
constexpr size_t WS_STOK  = WS_TOKS + 256 * 1024;
constexpr size_t WS_SGATE = WS_STOK + 272 * 1024;
constexpr size_t WS_CNT   = WS_SGATE + 272 * 1024;
constexpr size_t WS_PBASE = WS_CNT + 8192;
static_assert(WS_PBASE + 64 <= 4 * MiB, "small arrays");
constexpr size_t WS_W = 4 * MiB;
constexpr size_t WO_IN   = 0;
constexpr size_t WO_P    = WO_IN + 2ull * NINP * D;
constexpr size_t WO_OUT  = WO_P + 2ull * D * D;
constexpr size_t WO_XQ   = WO_OUT + 2ull * D * D;
constexpr size_t WO_XKV  = WO_XQ + 2ull * 512 * D;
constexpr size_t WO_XO   = WO_XKV + 2ull * D * D;
constexpr size_t WO_GUD  = WO_XO + 2ull * D * 512;
constexpr size_t WO_DND  = WO_GUD + 2ull * DFF * D;
constexpr size_t WO_GUM  = WO_DND + (size_t)D * DFF;
constexpr size_t WO_DNM  = WO_GUM + 8ull * 2 * DFFE * D;
constexpr size_t WO_END  = WO_DNM + 8ull * D * DFFE;
static_assert(WO_END * 2 <= 224 * MiB, "weights fit");
constexpr size_t WS_XN   = 228 * MiB;
constexpr size_t WS_PART = WS_XN;
constexpr size_t WS_TMAP = WS_CTL + 64 * 1024;
constexpr size_t WS_R    = 292 * MiB;
constexpr size_t WS_QKV  = WS_R;
constexpr size_t WS_GATES= WS_R + 144 * MiB;
constexpr size_t WS_O    = WS_R + 336 * MiB;
constexpr size_t WS_MB   = WS_R + 400 * MiB;
constexpr size_t WS_MEMN = WS_R + 464 * MiB;
constexpr size_t WS_MEMKV= WS_R + 480 * MiB;
constexpr size_t WS_MF   = WS_R;
constexpr size_t WS_QX   = WS_R;
constexpr size_t WS_OX   = WS_R + 32 * MiB;
constexpr size_t WS_ACTD = WS_R;
constexpr size_t WS_AG   = WS_R;
constexpr size_t WS_Y    = WS_R;
constexpr size_t WS_ACTM = WS_R + 132 * MiB;
constexpr size_t WS_END  = WS_ACTM + 462 * MiB;
static_assert((size_t)MAXSLOT * DFFE * 2 <= 462 * MiB && (size_t)MAXSLOT * D * 2 <= 132 * MiB, "moe buffers");

constexpr int CW_BAR = 4096;

constexpr int RING_BYTES = 131072;
constexpr int LDS_BYTES = 163840;
constexpr int LDSCTL_OFF = LDS_BYTES - 1024, MISC_OFF = LDSCTL_OFF + 320;
constexpr int NWAVES = 8, NTHR = 512;

typedef GAS unsigned gu32;
#define RLX_AGENT __ATOMIC_RELAXED, __HIP_MEMORY_SCOPE_AGENT
#define LDS_WAIT() asm volatile("s_waitcnt lgkmcnt(0)" ::: "memory")
#define VM_WAIT() asm volatile("s_waitcnt vmcnt(0)" ::: "memory")

#define XB_TMO      128
#define XB_XCNT(j)  (256  + 64 * (j))
#define XB_XSUB(j)  (1280 + 64 * (j))
#define XB_XGEN(j)  (2304 + 64 * (j))
#define XB_TOP      3328
#define XB_TOPGEN   3392
#define XCD_BAR_WORDS 3456
#define XB_SPIN_CAP (1u << 22)

__device__ __forceinline__ unsigned xb_ld(unsigned* p)              { return __hip_atomic_load(p, __ATOMIC_RELAXED, __HIP_MEMORY_SCOPE_AGENT); }
__device__ __forceinline__ unsigned xb_add(unsigned* p, unsigned v) { return __hip_atomic_fetch_add(p, v, __ATOMIC_RELAXED, __HIP_MEMORY_SCOPE_AGENT); }
__device__ __forceinline__ unsigned xb_xcc_id() { return (unsigned)__builtin_amdgcn_s_getreg((3 << 11) | 20) & 0xFu; }
#define XB_SPIN(cond, bar) do { unsigned _sp = 0; while (cond) { __builtin_amdgcn_s_sleep(1); \
    if ((++_sp & 255u) == 0u) { if (xb_ld(&(bar)[XB_TMO])) break; if (_sp > XB_SPIN_CAP) { atomicAdd(&(bar)[XB_TMO], 1u); break; } } } } while (0)

struct XcdBarrier { unsigned* bar; unsigned x; volatile LAS unsigned* st; };

__device__ __forceinline__ XcdBarrier xcd_barrier_post(unsigned* bar, volatile LAS unsigned* st) {
    XcdBarrier b; b.bar = bar; b.x = xb_xcc_id(); b.st = st;
    if (threadIdx.x == 0) (void)xb_add(&bar[XB_XCNT(b.x)], 1u);
    return b;
}
__device__ __forceinline__ void xcd_barrier_complete(unsigned* bar, unsigned x, unsigned& nloc, unsigned& nx) {
    const unsigned G = gridDim.x * gridDim.y * gridDim.z;
    unsigned sum, cnt, mine, sp = 0u;
    for (;;) {
        sum = 0u; cnt = 0u; mine = 0u;
#pragma unroll
        for (unsigned j = 0; j < 16; ++j) { const unsigned c = xb_ld(&bar[XB_XCNT(j)]); sum += c; cnt += (c > 0u) ? 1u : 0u; mine = (j == x) ? c : mine; }
        if (sum == G) break;
        __builtin_amdgcn_s_sleep(1);
        if ((++sp & 255u) == 0u) { if (xb_ld(&bar[XB_TMO])) break; if (sp > XB_SPIN_CAP) { atomicAdd(&bar[XB_TMO], 1u); break; } }
    }
    nloc = mine > 0u ? mine : 1u; nx = cnt > 0u ? cnt : 1u;
}
__device__ __forceinline__ void xcd_barrier_impl(unsigned* bar0, unsigned x, volatile LAS unsigned* st) {
    asm volatile("" : "+s"(bar0), "+s"(x));
    XcdBarrier b; b.bar = bar0; b.x = x; b.st = st;
    asm volatile("s_waitcnt vmcnt(0)" ::: "memory");
    __syncthreads();
    if (threadIdx.x == 0) {
        unsigned* bar = b.bar;
        __builtin_amdgcn_s_waitcnt(0);
        unsigned nloc = b.st[0], nx = b.st[1];
        if (nloc == 0u) { xcd_barrier_complete(bar, b.x, nloc, nx); b.st[0] = nloc; b.st[1] = nx; }
        const unsigned old = xb_add(&bar[XB_XSUB(b.x)], 1u);
        const unsigned gen = old / nloc;
        if (old + 1u == (gen + 1u) * nloc) {
            __builtin_amdgcn_fence(__ATOMIC_RELEASE, "agent");
            asm volatile("s_waitcnt vmcnt(0)" ::: "memory");
            const unsigned og = xb_add(&bar[XB_TOP], 1u);
            const unsigned tg = og / nx;
            if (og + 1u == (tg + 1u) * nx) xb_add(&bar[XB_TOPGEN], 1u);
            else XB_SPIN(xb_ld(&bar[XB_TOPGEN]) == tg, bar);
            __builtin_amdgcn_fence(__ATOMIC_ACQUIRE, "agent");
            xb_add(&bar[XB_XGEN(b.x)], 1u);
            asm volatile("s_waitcnt vmcnt(0)" ::: "memory");
        } else {
            XB_SPIN(xb_ld(&bar[XB_XGEN(b.x)]) == gen, bar);
            __builtin_amdgcn_fence(__ATOMIC_ACQUIRE, "agent");
            asm volatile("s_waitcnt vmcnt(0)" ::: "memory");
        }
    }
    __syncthreads();
}
__device__ __forceinline__ void xcd_barrier(const XcdBarrier& b) { xcd_barrier_impl(b.bar, b.x, b.st); }

__device__ __forceinline__ float wave_sum(float v, int lane) {
#pragma unroll
    for (int o = 1; o < 64; o <<= 1) v += shx(v, o, lane);
    return v;
}
template <int CTRL> __device__ __forceinline__ float dpp_max_step(float x) { const int xi = __builtin_bit_cast(int, x); return fmaxf(x, __builtin_bit_cast(float, __builtin_amdgcn_update_dpp(xi, xi, CTRL, 0xf, 0xf, false))); }
__device__ __forceinline__ float wave_max_dpp(float x) {
    x = dpp_max_step<0x111>(x); x = dpp_max_step<0x112>(x); x = dpp_max_step<0x114>(x); x = dpp_max_step<0x118>(x); x = dpp_max_step<0x142>(x); x = dpp_max_step<0x143>(x);
    return __builtin_bit_cast(float, __builtin_amdgcn_readlane(__builtin_bit_cast(int, x), 63));
}
__device__ __forceinline__ float wave_max(float v, int lane) {
#pragma unroll
    for (int o = 1; o < 64; o <<= 1) v = fmaxf(v, shx(v, o, lane));
    return v;
}
__device__ __forceinline__ int t5_bucket(int rel) {
    const int n = rel < 0 ? 0 : rel;
    if (n < 16) return n;
    const int large = 16 + (int)(logf((float)n / 16.0f) / 2.0794415416798357f * 16.0f);
    return large < 31 ? large : 31;
}

struct CvtJob { const float* W; int K, Nsrc, Ndst, ldd, kd0, map, dff; bf16_t* WT; };
__device__ __forceinline__ int cvt_srccol(const CvtJob& J, int n0) {
    if (J.map == 0) return n0;
    if (J.map == 1) {
        if (n0 >= NHEADC) return 2244 + (n0 - NHEADC);
        const int pn = n0 >> 8, p = n0 & 255, bj = p >> 7, wc = (p & 127) >> 5, slot = 4 * pn + wc;
        if (slot == 35) return -1;
        return (slot < 23 ? 64 * slot : 1476 + 64 * (slot - 23)) + 32 * bj;
    }
    const int pn = n0 >> 8, p = n0 & 255, bj = p >> 7, w = p & 127;
    return bj * J.dff + 128 * pn + w;
}
__device__ __forceinline__ void cvt_item(const CvtJob& J, LAS float* scr, int item, int lane) {
    const int nblk = J.Ndst / 32, kb = item / nblk, nb = item % nblk, k0 = 64 * kb, n0 = 32 * nb;
    const int sc = cvt_srccol(J, n0);
    if (sc >= 0) {
#pragma unroll
        for (int i = 0; i < 32; ++i) { const int kk = 2 * i + (lane >> 5); scr[kk * 33 + (lane & 31)] = J.W[(size_t)(k0 + kk) * J.Nsrc + sc + (lane & 31)]; }
    } else {
#pragma unroll 8
        for (int i = 0; i < 32; ++i) { const int kk = 2 * i + (lane >> 5); scr[kk * 33 + (lane & 31)] = 0.f; }
    }
    LDS_WAIT(); asm volatile("" ::: "memory");
    const int c = lane & 7;
#pragma unroll
    for (int j = 0; j < 4; ++j) { const int n = (lane >> 3) + 8 * j; const LAS float* s = scr + (8 * c) * 33 + n;
        u32x4 o; o.x = pk2(s[0 * 33], s[1 * 33]); o.y = pk2(s[2 * 33], s[3 * 33]); o.z = pk2(s[4 * 33], s[5 * 33]); o.w = pk2(s[6 * 33], s[7 * 33]);
        *(GAS u32x4*)(J.WT + (size_t)(n0 + n) * J.ldd + J.kd0 + k0 + 8 * c) = o; }
    LDS_WAIT(); asm volatile("" ::: "memory");
}
template <bool XB> __device__ __forceinline__ f32x4 ldx4(const void* x, size_t off) {
    if (XB) { const u32x2 w = *(const u32x2*)((const bf16_t*)x + off); return f32x4{bflo(w.x), bfhi(w.x), bflo(w.y), bfhi(w.y)}; }
    return *(const f32x4*)((const float*)x + off);
}
template <int NP, bool XB>
__device__ __forceinline__ void norm_rows(const void* x, int ldx, const float* gain, bf16_t* xn, int nrows, const float* Wp, int ldwp, float* proj, int gw, int ngw, int lane) {
    f32x4 g[4];
#pragma unroll
    for (int j = 0; j < 4; ++j) g[j] = *(const f32x4*)(gain + 4 * lane + 256 * j);
    float wp[NP > 0 ? NP : 1][16];
    if (NP > 0) {
#pragma unroll
        for (int j = 0; j < 4; ++j)
#pragma unroll
            for (int i = 0; i < 4; ++i)
#pragma unroll
                for (int c = 0; c < NP; ++c) wp[c][4 * j + i] = Wp[(size_t)(4 * lane + 256 * j + i) * ldwp + c];
    }
    for (int m = gw; m < nrows; m += ngw) {
        f32x4 v[4]; float s = 0.f;
#pragma unroll
        for (int j = 0; j < 4; ++j) { v[j] = ldx4<XB>(x, (size_t)m * ldx + 4 * lane + 256 * j); s += (v[j].x * v[j].x + v[j].y * v[j].y) + (v[j].z * v[j].z + v[j].w * v[j].w); }
        const float r = 1.0f / sqrtf(wave_sum(s, lane) * (1.0f / D) + EPS);
#pragma unroll
        for (int j = 0; j < 4; ++j) v[j] = v[j] * r * g[j];
        unsigned long long* o8 = (unsigned long long*)(xn + (size_t)m * D) + lane;
#pragma unroll
        for (int j = 0; j < 4; ++j) o8[64 * j] = (unsigned long long)pk2(v[j].x, v[j].y) | ((unsigned long long)pk2(v[j].z, v[j].w) << 32);
        if (NP > 0) {
#pragma unroll
            for (int c = 0; c < NP; ++c) { float a = 0.f;
#pragma unroll
                for (int j = 0; j < 4; ++j) a += (v[j].x * wp[c][4 * j] + v[j].y * wp[c][4 * j + 1]) + (v[j].z * wp[c][4 * j + 2] + v[j].w * wp[c][4 * j + 3]);
                a = wave_sum(a, lane);
                if (lane == 0) proj[(size_t)m * NP + c] = a; }
        }
    }
}
__device__ __forceinline__ void norm_router(const bf16_t* x, int ldx, const float* gain, bf16_t* xn, const float* Wr  , int* tok_e, float* tok_g, int* cnt  , LAS int* lcnt, int vb, int G, int wave, int lane) {
    f32x4 g[4];
#pragma unroll
    for (int j = 0; j < 4; ++j) g[j] = *(const f32x4*)(gain + 4 * lane + 256 * j);
    float wp[NEXP][16];
#pragma unroll
    for (int j = 0; j < 4; ++j)
#pragma unroll
        for (int i = 0; i < 4; ++i) { const f32x4 a = *(const f32x4*)(Wr + (size_t)(4 * lane + 256 * j + i) * NEXP), b = *(const f32x4*)(Wr + (size_t)(4 * lane + 256 * j + i) * NEXP + 4);
            wp[0][4 * j + i] = a.x; wp[1][4 * j + i] = a.y; wp[2][4 * j + i] = a.z; wp[3][4 * j + i] = a.w; wp[4][4 * j + i] = b.x; wp[5][4 * j + i] = b.y; wp[6][4 * j + i] = b.z; wp[7][4 * j + i] = b.w; }
    for (int c = vb; c < T / 128; c += G) {
        __syncthreads();
        if (threadIdx.x < NEXP) lcnt[threadIdx.x] = 0;
        __syncthreads();
        for (int rr = 0; rr < 16; ++rr) {
            const int m = c * 128 + wave * 16 + rr;
            f32x4 v[4]; float s = 0.f;
#pragma unroll
            for (int j = 0; j < 4; ++j) { v[j] = ldx4<true>(x, (size_t)m * ldx + 4 * lane + 256 * j); s += (v[j].x * v[j].x + v[j].y * v[j].y) + (v[j].z * v[j].z + v[j].w * v[j].w); }
            const float r = 1.0f / sqrtf(wave_sum(s, lane) * (1.0f / D) + EPS);
#pragma unroll
            for (int j = 0; j < 4; ++j) v[j] = v[j] * r * g[j];
            unsigned long long* o8 = (unsigned long long*)(xn + (size_t)m * D) + lane;
#pragma unroll
            for (int j = 0; j < 4; ++j) o8[64 * j] = (unsigned long long)pk2(v[j].x, v[j].y) | ((unsigned long long)pk2(v[j].z, v[j].w) << 32);
            float a8[NEXP];
#pragma unroll
            for (int e = 0; e < NEXP; ++e) { float a = 0.f;
#pragma unroll
                for (int j = 0; j < 4; ++j) a += (v[j].x * wp[e][4 * j] + v[j].y * wp[e][4 * j + 1]) + (v[j].z * wp[e][4 * j + 2] + v[j].w * wp[e][4 * j + 3]);
                a8[e] = a; }
            float b4[4], b2[2], b1;
            { const bool up = (lane & 32) != 0;
#pragma unroll
              for (int i = 0; i < 4; ++i) { const float keep = up ? a8[4 + i] : a8[i], send = up ? a8[i] : a8[4 + i]; b4[i] = keep + shx(send, 32, lane); } }
            { const bool up = (lane & 16) != 0;
#pragma unroll
              for (int i = 0; i < 2; ++i) { const float keep = up ? b4[2 + i] : b4[i], send = up ? b4[i] : b4[2 + i]; b2[i] = keep + shx(send, 16, lane); } }
            { const bool up = (lane & 8) != 0; const float keep = up ? b2[1] : b2[0], send = up ? b2[0] : b2[1]; b1 = keep + shx(send, 8, lane); }
            b1 += shx(b1, 4, lane); b1 += shx(b1, 2, lane); b1 += shx(b1, 1, lane);
            float lg[NEXP];
#pragma unroll
            for (int e = 0; e < NEXP; ++e) lg[e] = __builtin_bit_cast(float, __builtin_amdgcn_readlane(__builtin_bit_cast(int, b1), ((e >> 2) << 5) | (((e >> 1) & 1) << 4) | ((e & 1) << 3)));
            int i1 = 0; float v1 = lg[0];
#pragma unroll
            for (int e = 1; e < NEXP; ++e) if (lg[e] > v1) { v1 = lg[e]; i1 = e; }
            int i2 = -1; float v2 = -INFINITY;
#pragma unroll
            for (int e = 0; e < NEXP; ++e) if (e != i1 && lg[e] > v2) { v2 = lg[e]; i2 = e; }
            const float e2 = __expf(v2 - v1), g1 = 1.0f / (1.0f + e2), g2 = e2 / (1.0f + e2);
            if (lane == 0) { tok_e[2 * m] = i1; tok_e[2 * m + 1] = i2; tok_g[2 * m] = g1; tok_g[2 * m + 1] = g2; atomicAdd((int*)&lcnt[i1], 1); atomicAdd((int*)&lcnt[i2], 1); }
        }
        __syncthreads();
        if (threadIdx.x < NEXP) cnt[c * NEXP + threadIdx.x] = lcnt[threadIdx.x];
    }
}
__device__ __forceinline__ void moe_assign(const int* cnt, const int* tok_e, const float* tok_g, int* tok_s, int* stok, float* sgate, int* pbase_out, const bf16_t* xn, bf16_t* ag, LAS int* lw, int vb, int G, int wave, int lane) {
    const int tid = wave * 64 + lane;
    for (int c = vb; c < T / 128; c += G) {
        __syncthreads();
        for (int i = tid; i < (T / 128) * NEXP; i += NTHR) lw[i] = cnt[i];
        if (tid < 256) lw[2100 + tid] = tok_e[c * 256 + tid];
        __syncthreads();
        if (tid < NEXP) { const int e = tid; int tot = 0, pre = 0;
            for (int cc = 0; cc < T / 128; ++cc) { const int v = lw[cc * NEXP + e]; tot += v; pre += (cc < c) ? v : 0; }
            lw[2048 + e] = tot; lw[2056 + e] = pre; }
        __syncthreads();
        if (tid == 0) { int pb = 0;
            for (int e = 0; e < NEXP; ++e) { lw[2064 + e] = pb; pb += (lw[2048 + e] + 255) >> 8; }
            lw[2064 + NEXP] = pb;
            if (c == 0) { for (int e = 0; e <= NEXP; ++e) pbase_out[e] = lw[2064 + e]; } }
        __syncthreads();
        if (tid < 256) { const int p = tid, e = lw[2100 + p]; int rank = 0;
            for (int q = 0; q < p; ++q) rank += (lw[2100 + q] == e) ? 1 : 0;
            const int pi = c * 256 + p, s = lw[2064 + e] * 256 + lw[2056 + e] + rank;
            tok_s[pi] = s; stok[s] = pi >> 1; sgate[s] = tok_g[pi]; lw[2400 + p] = s; }
        __syncthreads();
        for (int p = wave * 32; p < wave * 32 + 32; ++p) { const int pi = c * 256 + p; const int s = lw[2400 + p]; const int tk = pi >> 1;
            const u32x4* src = (const u32x4*)(xn + (size_t)tk * D) + lane; u32x4* dst = (u32x4*)(ag + (size_t)s * D) + lane;
            const u32x4 a = src[0], b = src[64]; dst[0] = a; dst[64] = b; }
    }
}
__device__ __forceinline__ void moe_combine(float* out, const bf16_t* xs, int ldx, const bf16_t* Y, const int* tok_s, const float* sgate, const float* part, const int* tmap, int tail, int S, int gw, int ngw, int lane) {
    for (int m = gw; m < T; m += ngw) {
        const int s0 = tok_s[2 * m], s1 = tok_s[2 * m + 1];
        f32x4* xr = (f32x4*)(out + (size_t)m * D) + lane;
        f32x4 v[4]; u32x2 ya[2][4]; u32x4 t4[2];
#pragma unroll
        for (int j = 0; j < 4; ++j) v[j] = ldx4<true>(xs, (size_t)m * ldx + 4 * lane + 256 * j);
#pragma unroll
        for (int k = 0; k < 2; ++k) { const int sl = k == 0 ? s0 : s1; const u32x2* y = (const u32x2*)(Y + (size_t)sl * D) + lane;
#pragma unroll
            for (int j = 0; j < 4; ++j) ya[k][j] = y[64 * j];
            t4[k] = *(const u32x4*)(tmap + (sl >> 8) * 4); }
#pragma unroll
        for (int k = 0; k < 2; ++k) { const int sl = k == 0 ? s0 : s1;
            const int any = __builtin_amdgcn_readfirstlane((int)(t4[k].x | t4[k].y | t4[k].z | t4[k].w));
            if (any == 0) {
#pragma unroll
                for (int j = 0; j < 4; ++j) { const u32x2 a = ya[k][j]; v[j].x += bflo(a.x); v[j].y += bfhi(a.x); v[j].z += bflo(a.y); v[j].w += bfhi(a.y); }
            } else {
                const int tm[4] = {__builtin_amdgcn_readfirstlane((int)t4[k].x), __builtin_amdgcn_readfirstlane((int)t4[k].y), __builtin_amdgcn_readfirstlane((int)t4[k].z), __builtin_amdgcn_readfirstlane((int)t4[k].w)};
                const float gt = sgate[sl];
#pragma unroll
                for (int j = 0; j < 4; ++j) {
                    if (tm[j] == 0) { const u32x2 a = ya[k][j]; v[j].x += bflo(a.x); v[j].y += bfhi(a.x); v[j].z += bflo(a.y); v[j].w += bfhi(a.y); }
                    else { const float* p = part + (size_t)(tm[j] - 1) * (256 * 256) + (size_t)(sl & 255) * 256 + 4 * lane;
                        f32x4 pa[14];
#pragma unroll
                        for (int s = 0; s < 14; ++s) pa[s] = *(const f32x4*)(p + (size_t)(s < S ? s : 0) * tail * (256 * 256));
                        f32x4 a = pa[0];
#pragma unroll
                        for (int s = 1; s < 14; ++s) a += pa[s] * (s < S ? 1.0f : 0.0f);
                        v[j] += a * gt; } } } }
        asm volatile("s_waitcnt vmcnt(0)" ::: "memory");
#pragma unroll
        for (int j = 0; j < 4; ++j) xr[64 * j] = v[j];
    }
}

__device__ __forceinline__ void ld8(const bf16_t* p, float* f) { const u32x4 w = *(const u32x4*)p; f[0] = bflo(w.x); f[1] = bfhi(w.x); f[2] = bflo(w.y); f[3] = bfhi(w.y); f[4] = bflo(w.z); f[5] = bfhi(w.z); f[6] = bflo(w.w); f[7] = bfhi(w.w); }
__device__ __forceinline__ void st8(bf16_t* p, const float* f) { u32x4 w; w.x = pk2(f[0], f[1]); w.y = pk2(f[2], f[3]); w.z = pk2(f[4], f[5]); w.w = pk2(f[6], f[7]); *(u32x4*)p = w; }

__device__ __forceinline__ void sb_naive(const bf16_t* QA, const bf16_t* KA, const bf16_t* VA, bf16_t* O, int gtid, int gthreads) {
    for (int item = gtid; item < T * 4; item += gthreads) {
        const int t = item % SEQ, h = (item / SEQ) & 3, b = item / (SEQ * 4);
        const size_t row = (size_t)b * SEQ + t;
        float q[64], o[64];
#pragma unroll
        for (int i = 0; i < 8; ++i) ld8(QA + row * 256 + h * 64 + 8 * i, q + 8 * i);
#pragma unroll
        for (int i = 0; i < 64; ++i) o[i] = 0.f;
        float run = 0.f;
        for (int s = t - 1; s >= 0; --s) {
            const size_t kr = ((size_t)b * SEQ + s) * 256 + h * 64;
            float dot = 0.f;
#pragma unroll
            for (int i = 0; i < 8; ++i) { float k[8]; ld8(KA + kr + 8 * i, k);
#pragma unroll
                for (int j = 0; j < 8; ++j) dot += q[8 * i + j] * k[j]; }
            const float z = dot * 0.125f;
            const float l1p = log1pf(expf(-fabsf(z)));
            const float log_beta = fminf(z, 0.f) - l1p, log_keep = fminf(-z, 0.f) - l1p;
            const float att = expf(log_beta + run);
#pragma unroll
            for (int i = 0; i < 8; ++i) { float v[8]; ld8(VA + kr + 8 * i, v);
#pragma unroll
                for (int j = 0; j < 8; ++j) o[8 * i + j] += att * v[j]; }
            run += log_keep;
            if (run < -104.f) break;
        }
#pragma unroll
        for (int i = 0; i < 8; ++i) st8(O + row * D + h * 64 + 8 * i, o + 8 * i);
    }
}
__device__ __forceinline__ void swa_naive(const bf16_t* QC, const bf16_t* KC, const bf16_t* VC, const float* sinks, const LAS float* brel  , bf16_t* O, int gtid, int gthreads) {
    for (int item = gtid; item < T * 8; item += gthreads) {
        const int h = item & 7; const int rowi = item >> 3; const int t = rowi % SEQ, b = rowi / SEQ, kv = h >> 2;
        float q[64], o[64];
#pragma unroll
        for (int i = 0; i < 8; ++i) ld8(QC + (size_t)rowi * 512 + h * 64 + 8 * i, q + 8 * i);
#pragma unroll
        for (int i = 0; i < 64; ++i) o[i] = 0.f;
        float mx = sinks[h], l = 1.0f;
        const int s0 = t - 127 < 0 ? 0 : t - 127;
        for (int s = s0; s <= t; ++s) {
            const size_t kr = ((size_t)b * SEQ + s) * 128 + kv * 64;
            float dot = 0.f;
#pragma unroll
            for (int i = 0; i < 8; ++i) { float k[8]; ld8(KC + kr + 8 * i, k);
#pragma unroll
                for (int j = 0; j < 8; ++j) dot += q[8 * i + j] * k[j]; }
            const float sc = dot * 0.125f + brel[(t - s) * 12 + 4 + h];
            if (sc > mx) { const float f = expf(mx - sc); l *= f;
#pragma unroll
                for (int i = 0; i < 64; ++i) o[i] *= f;
                mx = sc; }
            const float p = expf(sc - mx); l += p;
#pragma unroll
            for (int i = 0; i < 8; ++i) { float v[8]; ld8(VC + kr + 8 * i, v);
#pragma unroll
                for (int j = 0; j < 8; ++j) o[8 * i + j] += p * v[j]; }
        }
        const float il = 1.0f / l;
#pragma unroll
        for (int i = 0; i < 64; ++i) o[i] *= il;
#pragma unroll
        for (int i = 0; i < 8; ++i) st8(O + (size_t)rowi * D + 512 + h * 64 + 8 * i, o + 8 * i);
    }
}
__device__ __forceinline__ void dsa_naive(const bf16_t* QB, const bf16_t* KB, const bf16_t* VB, const bf16_t* QI, const bf16_t* KI, const float* WI, const LAS float* brel, bf16_t* O, LAS unsigned char* wl, int gw, int ngw, int lane) {
    LAS float* sqi = (LAS float*)wl; LAS float* sqb = sqi + 256; LAS int* sidx = (LAS int*)(sqi + 512); LAS float* sp = sqi + 768;
    const unsigned long long ltmask = (1ull << lane) - 1ull;
    for (int qrow = gw; qrow < T; qrow += ngw) {
        const int b = qrow / SEQ, t = qrow % SEQ;
        { const u32x2 a = *(const u32x2*)(QI + (size_t)qrow * 256 + 4 * lane), c = *(const u32x2*)(QB + (size_t)qrow * 256 + 4 * lane);
          sqi[4 * lane] = bflo(a.x); sqi[4 * lane + 1] = bfhi(a.x); sqi[4 * lane + 2] = bflo(a.y); sqi[4 * lane + 3] = bfhi(a.y);
          sqb[4 * lane] = bflo(c.x); sqb[4 * lane + 1] = bfhi(c.x); sqb[4 * lane + 2] = bflo(c.y); sqb[4 * lane + 3] = bfhi(c.y); }
        const f32x4 wi = *(const f32x4*)(WI + (size_t)qrow * 4);
        LDS_WAIT(); asm volatile("" ::: "memory");
        unsigned key[32];
#pragma unroll
        for (int r = 0; r < 32; ++r) {
            key[r] = 0u;
            if (64 * r <= t) {
                const int s = 64 * r + lane;
                if (s <= t) {
                    float dd[4] = {0.f, 0.f, 0.f, 0.f};
#pragma unroll
                    for (int i = 0; i < 8; ++i) { float k[8]; ld8(KI + ((size_t)b * SEQ + s) * 64 + 8 * i, k);
#pragma unroll
                        for (int h = 0; h < 4; ++h)
#pragma unroll
                            for (int j = 0; j < 8; ++j) dd[h] += sqi[h * 64 + 8 * i + j] * k[j]; }
                    float sc = 0.f;
#pragma unroll
                    for (int h = 0; h < 4; ++h) { const float d = dd[h] * 0.125f; sc += wi[h] * (d > 0.f ? d : 0.f); }
                    const unsigned u = __builtin_bit_cast(unsigned, sc);
                    key[r] = (u & 0x80000000u) ? ~u : (u | 0x80000000u);
                }
            }
        }
        const int nvalid = t + 1;
        unsigned tau = 0u; int need = 0;
        if (nvalid > 256) {
            unsigned lo = 0u, hi = 0xFFFFFFFFu;
            while (hi - lo > 1u) { const unsigned mid = lo + ((hi - lo) >> 1); int c = 0;
#pragma unroll
                for (int r = 0; r < 32; ++r) c += __popcll(__ballot(key[r] > mid));
                if (c >= 256) lo = mid; else hi = mid; }
            tau = hi; int ngt = 0;
#pragma unroll
            for (int r = 0; r < 32; ++r) ngt += __popcll(__ballot(key[r] > tau));
            need = 256 - ngt;
        }
        int pos = 0, tie_seen = 0;
#pragma unroll
        for (int r = 0; r < 32; ++r) {
            const bool gt = key[r] > tau; const bool eq = (nvalid > 256) && (key[r] == tau);
            const unsigned long long meq = __ballot(eq);
            const bool sel = gt || (eq && (tie_seen + __popcll(meq & ltmask)) < need);
            tie_seen += __popcll(meq);
            const unsigned long long ms = __ballot(sel);
            if (sel) sidx[pos + __popcll(ms & ltmask)] = 64 * r + lane;
            pos += __popcll(ms);
        }
        const int nsel = pos;
        LDS_WAIT(); asm volatile("" ::: "memory");
        float sc4[4][4];
#pragma unroll
        for (int i = 0; i < 4; ++i) { const int j = lane + 64 * i;
            if (j < nsel) { const int s = sidx[j]; float dd[4] = {0.f, 0.f, 0.f, 0.f};
#pragma unroll
                for (int ii = 0; ii < 8; ++ii) { float k[8]; ld8(KB + ((size_t)b * SEQ + s) * 64 + 8 * ii, k);
#pragma unroll
                    for (int h = 0; h < 4; ++h)
#pragma unroll
                        for (int jj = 0; jj < 8; ++jj) dd[h] += sqb[h * 64 + 8 * ii + jj] * k[jj]; }
                int rel = t - s; rel = rel > 127 ? 127 : rel;
#pragma unroll
                for (int h = 0; h < 4; ++h) sc4[i][h] = dd[h] * 0.125f + brel[rel * 12 + h];
            } else {
#pragma unroll
                for (int h = 0; h < 4; ++h) sc4[i][h] = -INFINITY; } }
#pragma unroll
        for (int h = 0; h < 4; ++h) {
            const float mx = wave_max(fmaxf(fmaxf(sc4[0][h], sc4[1][h]), fmaxf(sc4[2][h], sc4[3][h])), lane);
            float e[4], su = 0.f;
#pragma unroll
            for (int i = 0; i < 4; ++i) { e[i] = expf(sc4[i][h] - mx); su += e[i]; }
            su = wave_sum(su, lane); const float inv = 1.0f / su;
#pragma unroll
            for (int i = 0; i < 4; ++i) sp[h * 256 + lane + 64 * i] = e[i] * inv;
        }
        LDS_WAIT(); asm volatile("" ::: "memory");
        float o[4] = {0.f, 0.f, 0.f, 0.f};
        for (int j = 0; j < nsel; ++j) { const int s = sidx[j]; const float v = bf2f(VB[((size_t)b * SEQ + s) * 64 + lane]);
#pragma unroll
            for (int h = 0; h < 4; ++h) o[h] += sp[h * 256 + j] * v; }
#pragma unroll
        for (int h = 0; h < 4; ++h) O[(size_t)qrow * D + 256 + h * 64 + lane] = (bf16_t)f2bf(o[h]);
        LDS_WAIT(); asm volatile("" ::: "memory");
    }
}
__device__ __forceinline__ float sum16(float v, int lane) { v += shx(v, 1, lane); v += shx(v, 2, lane); v += shx(v, 4, lane); v += shx(v, 8, lane); return v; }
__device__ __forceinline__ void xattn_naive(const bf16_t* QX, const bf16_t* MKV  , const float* qn, bf16_t* OX, int gw, int ngw, int lane) {
    const int h = lane >> 4, part = lane & 15;
    float gq[8];
#pragma unroll
    for (int i = 0; i < 8; ++i) gq[i] = qn[part * 8 + i];
    for (int row = gw; row < T; row += ngw) {
        const int b = row / SEQ;
        float q[8]; ld8(QX + (size_t)row * 512 + h * 128 + part * 8, q);
        float ss = 0.f;
#pragma unroll
        for (int i = 0; i < 8; ++i) ss += q[i] * q[i];
        ss = sum16(ss, lane);
        const float r = 1.0f / sqrtf(ss * (1.0f / 128.0f) + EPS) * 0.08838834764831845f;
#pragma unroll
        for (int i = 0; i < 8; ++i) q[i] = q[i] * r * gq[i];
        float mx = -INFINITY, l = 0.f, o[8];
#pragma unroll
        for (int i = 0; i < 8; ++i) o[i] = 0.f;
        for (int j = 0; j < NMEM; ++j) {
            const bf16_t* kp = MKV + ((size_t)b * NMEM + j) * D + h * 128 + part * 8;
            float k[8], v[8]; ld8(kp, k); ld8(kp + 512, v);
            float d = 0.f;
#pragma unroll
            for (int i = 0; i < 8; ++i) d += q[i] * k[i];
            d = sum16(d, lane);
            if (d > mx) { const float f = expf(mx - d); l *= f;
#pragma unroll
                for (int i = 0; i < 8; ++i) o[i] *= f;
                mx = d; }
            const float p = expf(d - mx); l += p;
#pragma unroll
            for (int i = 0; i < 8; ++i) o[i] += p * v[i];
        }
        const float il = 1.0f / l;
#pragma unroll
        for (int i = 0; i < 8; ++i) o[i] *= il;
        st8(OX + (size_t)row * 512 + h * 128 + part * 8, o);
    }
}
__device__ __forceinline__ void memk_norm(bf16_t* MKV  , const float* kn_x  , int gw, int ngw, int lane) {
    const int h = lane >> 4, part = lane & 15;
    for (int row = gw; row < 2 * TM; row += ngw) {
        const int l = row / TM;
        bf16_t* kp = MKV + (size_t)row * D + h * 128 + part * 8;
        float k[8]; ld8(kp, k);
        float ss = 0.f;
#pragma unroll
        for (int i = 0; i < 8; ++i) ss += k[i] * k[i];
        ss = sum16(ss, lane);
        const float r = 1.0f / sqrtf(ss * (1.0f / 128.0f) + EPS);
#pragma unroll
        for (int i = 0; i < 8; ++i) k[i] = k[i] * r * kn_x[l * 128 + part * 8 + i];
        st8(kp, k);
    }
}
typedef float f32x16 __attribute__((ext_vector_type(16)));
typedef short s16x4 __attribute__((ext_vector_type(4)));
#define LOG2E 1.4426950408889634f
#ifndef KDIRECT
#define KDIRECT 0
#endif
__device__ __forceinline__ f32x16 zero16() { float z = 0.f; asm volatile("" : "+v"(z)); return (f32x16){z, z, z, z, z, z, z, z, z, z, z, z, z, z, z, z}; }
__device__ __forceinline__ int crow(int r, int hi) { return (r & 3) + 8 * (r >> 2) + 4 * hi; }
__device__ __forceinline__ void xhalf_pair(float v, float& own_lo, float& own_hi) { float a = v, b = v;
    asm volatile("s_nop 1\n\tv_permlane32_swap_b32 %0, %1\n\ts_nop 1" : "+v"(a), "+v"(b)); own_lo = a; own_hi = b; }
__device__ __forceinline__ float xhalf_max(float v) { float x, y; xhalf_pair(v, x, y); return fmaxf(x, y); }
__device__ __forceinline__ float xhalf_sum(float v) { float x, y; xhalf_pair(v, x, y); return x + y; }

__device__ __forceinline__ s16x4 vtr(const LAS unsigned char* p) { return __builtin_bit_cast(s16x4, __builtin_amdgcn_ds_read_tr16_b64_v4i16((LAS s16x4*)p)); }
__device__ __forceinline__ bf16x8 mk8(s16x4 lo, s16x4 hi) { return (bf16x8){lo[0], lo[1], lo[2], lo[3], hi[0], hi[1], hi[2], hi[3]}; }
__device__ __forceinline__ bf16x8 pack8(const float* p) { u32x4 w; w.x = cvt_pk_bf16(p[0], p[1]); w.y = cvt_pk_bf16(p[2], p[3]); w.z = cvt_pk_bf16(p[4], p[5]); w.w = cvt_pk_bf16(p[6], p[7]); return __builtin_bit_cast(bf16x8, w); }
__device__ __forceinline__ int vtr_base(int lane, int vstr) { const int hi = lane >> 5, g1 = (lane >> 4) & 1, i = lane & 15; return (4 * hi + (i >> 2)) * vstr + (16 * g1 + 4 * (i & 3)) * 2; }

__device__ __forceinline__ void xattn_mfma(const bf16_t* QX, const bf16_t* MKV, const float* qn, bf16_t* OX, LAS unsigned char* lds, int vcu, int G, int tid) {
    const int lane = tid & 63, wave = __builtin_amdgcn_readfirstlane(tid >> 6), c = lane & 31, hi = lane >> 5;
    constexpr int KSTR = 272, VSTR = 320, VOFF = 256 * KSTR;
    const int vb = VOFF + vtr_base(lane, VSTR);
    for (int unit = vcu; unit < BATCH * 4 * 8; unit += G) {
        const int b = unit >> 5, h = (unit >> 3) & 3, qb = unit & 7;
        const size_t qrow = (size_t)b * SEQ + qb * 256 + wave * 32 + c;
        __syncthreads();
#pragma unroll 4
        for (int i = 0; i < 8; ++i) { const int id = tid + 512 * i, row = id >> 4, ch = id & 15;
            const bf16_t* src = MKV + ((size_t)(b * NMEM + row)) * D + h * 128 + ch * 8;
            *(LAS u32x4*)(lds + row * KSTR + ch * 16) = *(const u32x4*)src; }
        asm volatile("" ::: "memory");
#pragma unroll 4
        for (int i = 0; i < 8; ++i) { const int id = tid + 512 * i, row = id >> 4, ch = id & 15;
            const bf16_t* src = MKV + ((size_t)(b * NMEM + row)) * D + 512 + h * 128 + ch * 8;
            *(LAS u32x4*)(lds + VOFF + row * VSTR + ch * 16) = *(const u32x4*)src; }
        asm volatile("" ::: "memory");
        bf16x8 qf[8];
        { float q[8][8]; float ss = 0.f;
#pragma unroll
          for (int ks = 0; ks < 8; ++ks) { ld8(QX + qrow * 512 + h * 128 + 16 * ks + 8 * hi, q[ks]);
#pragma unroll
              for (int j = 0; j < 8; ++j) ss += q[ks][j] * q[ks][j]; }
          ss = xhalf_sum(ss);
          const float r = 1.0f / sqrtf(ss * (1.0f / 128.0f) + EPS) * (0.08838834764831845f * LOG2E);
#pragma unroll
          for (int ks = 0; ks < 8; ++ks) { float t[8];
#pragma unroll
              for (int j = 0; j < 8; ++j) t[j] = q[ks][j] * r * qn[16 * ks + 8 * hi + j];
              qf[ks] = pack8(t); } }
        __syncthreads();
        f32x16 O[4];
#pragma unroll
        for (int dt = 0; dt < 4; ++dt) O[dt] = zero16();
        float m = -1e30f, l = 0.f;
        for (int kt = 0; kt < 8; ++kt) {
            f32x16 S = zero16();
#pragma unroll
            for (int ks = 0; ks < 8; ++ks) {
#if KDIRECT
                const bf16x8 kf = *(const bf16x8*)(MKV + ((size_t)(b * NMEM + kt * 32 + c)) * D + h * 128 + 16 * ks + 8 * hi);
#else
                const bf16x8 kf = *(const LAS bf16x8*)(lds + (kt * 32 + c) * KSTR + (16 * ks + 8 * hi) * 2);
#endif
                S = __builtin_amdgcn_mfma_f32_32x32x16_bf16(kf, qf[ks], S, 0, 0, 0); }
            float tm = S[0];
#pragma unroll
            for (int r = 1; r < 16; ++r) tm = fmaxf(tm, S[r]);
            const float mn = fmaxf(m, xhalf_max(tm));
            const float f = __builtin_amdgcn_exp2f(m - mn); m = mn;
            float p[16], ps = 0.f;
#pragma unroll
            for (int r = 0; r < 16; ++r) { p[r] = __builtin_amdgcn_exp2f(S[r] - mn); ps += p[r]; }
            l = l * f + ps;
#pragma unroll
            for (int dt = 0; dt < 4; ++dt) O[dt] *= f;
            const bf16x8 pf0 = pack8(p), pf1 = pack8(p + 8);
#pragma unroll
            for (int dt = 0; dt < 4; ++dt) { const LAS unsigned char* vp = lds + vb + (kt * 32) * VSTR + dt * 64;
                const bf16x8 v0 = mk8(vtr(vp), vtr(vp + 8 * VSTR)), v1 = mk8(vtr(vp + 16 * VSTR), vtr(vp + 24 * VSTR));
                O[dt] = __builtin_amdgcn_mfma_f32_32x32x16_bf16(v0, pf0, O[dt], 0, 0, 0);
                O[dt] = __builtin_amdgcn_mfma_f32_32x32x16_bf16(v1, pf1, O[dt], 0, 0, 0); }
        }
        const float il = 1.0f / xhalf_sum(l);
#pragma unroll
        for (int dt = 0; dt < 4; ++dt)
#pragma unroll
            for (int g = 0; g < 4; ++g) { u32x2 w; w.x = cvt_pk_bf16(O[dt][4 * g] * il, O[dt][4 * g + 1] * il); w.y = cvt_pk_bf16(O[dt][4 * g + 2] * il, O[dt][4 * g + 3] * il);
                *(u32x2*)(OX + qrow * 512 + h * 128 + dt * 32 + 8 * g + 4 * hi) = w; }
    }
}

__device__ __forceinline__ void swa_mfma(const bf16_t* QC, const bf16_t* KC, const bf16_t* VC, const float* sinks, const LAS float* brel, bf16_t* O, LAS unsigned char* lds, int vcu, int G, int tid) {
    const int lane = tid & 63, wave = __builtin_amdgcn_readfirstlane(tid >> 6), c = lane & 31, hi = lane >> 5;
    constexpr int KSTR = 144, VSTR = 192, VOFF = 192 * KSTR;
    const int vb = VOFF + vtr_base(lane, VSTR);
    const int g = wave >> 1, qh = wave & 1;
    for (int unit = vcu; unit < BATCH * 2 * 32; unit += G) {
        const int b = unit >> 6, kvh = (unit >> 5) & 1, qb = unit & 31, q0 = qb * 64, head = kvh * 4 + g;
        __syncthreads();
#pragma unroll
        for (int i = 0; i < 3; ++i) { const int id = tid + 512 * i, row = id >> 3, ch = id & 7; int kr = q0 - 128 + row; kr = kr < 0 ? 0 : kr;
            const size_t src = ((size_t)b * SEQ + kr) * 128 + kvh * 64 + ch * 8;
            *(LAS u32x4*)(lds + row * KSTR + ch * 16) = *(const u32x4*)(KC + src);
            *(LAS u32x4*)(lds + VOFF + row * VSTR + ch * 16) = *(const u32x4*)(VC + src); }
        const int t = q0 + 32 * qh + c; const size_t qrow = (size_t)b * SEQ + t;
        bf16x8 qf[4];
#pragma unroll
        for (int ks = 0; ks < 4; ++ks) qf[ks] = *(const bf16x8*)(QC + qrow * 512 + head * 64 + 16 * ks + 8 * hi);
        const float sink = sinks[head] * LOG2E;
        __syncthreads();
        f32x16 Oa[2];
#pragma unroll
        for (int dt = 0; dt < 2; ++dt) Oa[dt] = zero16();
        float m = sink, l = 0.5f;
        const int rb = c + 128 - 4 * hi;
        const int sp0 = q0 - 128 + 32 * qh + 4 * hi;
        const LAS float* bh = brel + 4 + head;
        for (int kt = 0; kt < 5; ++kt) {
            f32x16 S = zero16();
#pragma unroll
            for (int ks = 0; ks < 4; ++ks) {
#if KDIRECT
                int kr = q0 - 128 + (kt + qh) * 32 + c; kr = kr < 0 ? 0 : kr;
                const bf16x8 kf = *(const bf16x8*)(KC + ((size_t)b * SEQ + kr) * 128 + kvh * 64 + 16 * ks + 8 * hi);
#else
                const bf16x8 kf = *(const LAS bf16x8*)(lds + ((kt + qh) * 32 + c) * KSTR + (16 * ks + 8 * hi) * 2);
#endif
                S = __builtin_amdgcn_mfma_f32_32x32x16_bf16(kf, qf[ks], S, 0, 0, 0); }
            float sv[16], tm = -1e30f;
#pragma unroll
            for (int r = 0; r < 16; ++r) { const int cr = 32 * kt + (r & 3) + 8 * (r >> 2);
                const int rel = rb - cr, spos = sp0 + cr;
                const int inv = (rel | (127 - rel) | spos) >> 31;
                const int relc = rel < 0 ? 0 : (rel > 127 ? 127 : rel);
                const float v = S[r] * (0.125f * LOG2E) + bh[relc * 12] * LOG2E;
                const float cap = __builtin_bit_cast(float, 0x7F800000u | ((unsigned)inv & 0x80000000u));
                sv[r] = fminf(v, cap); tm = fmaxf(tm, sv[r]); }
            const float mn = fmaxf(m, xhalf_max(tm));
            const float f = __builtin_amdgcn_exp2f(m - mn); m = mn;
            float p[16], ps = 0.f;
#pragma unroll
            for (int r = 0; r < 16; ++r) { p[r] = __builtin_amdgcn_exp2f(sv[r] - mn); ps += p[r]; }
            l = l * f + ps;
#pragma unroll
            for (int dt = 0; dt < 2; ++dt) Oa[dt] *= f;
            const bf16x8 pf0 = pack8(p), pf1 = pack8(p + 8);
#pragma unroll
            for (int dt = 0; dt < 2; ++dt) { const LAS unsigned char* vp = lds + vb + ((kt + qh) * 32) * VSTR + dt * 64;
                const bf16x8 v0 = mk8(vtr(vp), vtr(vp + 8 * VSTR)), v1 = mk8(vtr(vp + 16 * VSTR), vtr(vp + 24 * VSTR));
                Oa[dt] = __builtin_amdgcn_mfma_f32_32x32x16_bf16(v0, pf0, Oa[dt], 0, 0, 0);
                Oa[dt] = __builtin_amdgcn_mfma_f32_32x32x16_bf16(v1, pf1, Oa[dt], 0, 0, 0); }
        }
        const float il = 1.0f / xhalf_sum(l);
#pragma unroll
        for (int dt = 0; dt < 2; ++dt)
#pragma unroll
            for (int gg = 0; gg < 4; ++gg) { u32x2 w; w.x = cvt_pk_bf16(Oa[dt][4 * gg] * il, Oa[dt][4 * gg + 1] * il); w.y = cvt_pk_bf16(Oa[dt][4 * gg + 2] * il, Oa[dt][4 * gg + 3] * il);
                *(u32x2*)(O + qrow * D + 512 + head * 64 + dt * 32 + 8 * gg + 4 * hi) = w; }
    }
}

__device__ __forceinline__ float log_sig(float z, float l1p) { return fminf(z, 0.f) - l1p; }
__device__ __forceinline__ void sb_mfma(const bf16_t* QA, const bf16_t* KA, const bf16_t* VA, bf16_t* O, LAS unsigned char* wl, int gw, int ngw, int lane) {
    const int c = lane & 31, hi = lane >> 5;
    constexpr int VSTR = 192;
    const int vb = vtr_base(lane, VSTR);
    for (int item = gw; item < BATCH * 4 * 64; item += ngw) {
        const int b = item >> 8, h = (item >> 6) & 3, qb = item & 63, q0 = qb * 32;
        const size_t qrow = (size_t)b * SEQ + q0 + c;
        bf16x8 qf[4];
#pragma unroll
        for (int ks = 0; ks < 4; ++ks) qf[ks] = *(const bf16x8*)(QA + qrow * 256 + h * 64 + 16 * ks + 8 * hi);
        f32x16 Oa[2];
#pragma unroll
        for (int dt = 0; dt < 2; ++dt) Oa[dt] = zero16();
        float carry = 0.f;
        bf16x8 kf[4], kn[4] = {}; u32x4 vr[4], vn[4] = {};
        { const size_t krow0 = (size_t)b * SEQ + qb * 32;
#pragma unroll
          for (int ks = 0; ks < 4; ++ks) kf[ks] = *(const bf16x8*)(KA + (krow0 + c) * 256 + h * 64 + 16 * ks + 8 * hi);
#pragma unroll
          for (int i = 0; i < 4; ++i) { const int id = lane + 64 * i, row = id >> 3, ch = id & 7; vr[i] = *(const u32x4*)(VA + (krow0 + row) * 256 + h * 64 + ch * 8); } }
        for (int kt = qb; kt >= 0; --kt) {
#pragma unroll
            for (int i = 0; i < 4; ++i) { const int id = lane + 64 * i, row = id >> 3, ch = id & 7; *(LAS u32x4*)(wl + row * VSTR + ch * 16) = vr[i]; }
            if (kt > 0) { const size_t krow1 = (size_t)b * SEQ + (kt - 1) * 32;
#pragma unroll
                for (int ks = 0; ks < 4; ++ks) kn[ks] = *(const bf16x8*)(KA + (krow1 + c) * 256 + h * 64 + 16 * ks + 8 * hi);
#pragma unroll
                for (int i = 0; i < 4; ++i) { const int id = lane + 64 * i, row = id >> 3, ch = id & 7; vn[i] = *(const u32x4*)(VA + (krow1 + row) * 256 + h * 64 + ch * 8); } }
            f32x16 S = zero16();
#pragma unroll
            for (int ks = 0; ks < 4; ++ks) S = __builtin_amdgcn_mfma_f32_32x32x16_bf16(kf[ks], qf[ks], S, 0, 0, 0);
            const bool diag = (kt == qb);
            float lk[16], lb[16];
            const int dm = diag ? (c - 1 - 4 * hi) : 64;
#pragma unroll
            for (int r = 0; r < 16; ++r) { const float z = S[r] * 0.125f; const float l1p = 0.6931471805599453f * __builtin_amdgcn_logf(1.0f + __builtin_amdgcn_exp2f(fabsf(z) * -1.4426950408889634f));
                const int inv = (dm - ((r & 3) + 8 * (r >> 2))) >> 31;
                const float cap = __builtin_bit_cast(float, 0x7F800000u | ((unsigned)inv & 0x80000000u));
                lb[r] = fminf(log_sig(z, l1p), cap);
                lk[r] = __builtin_bit_cast(float, __builtin_bit_cast(unsigned, log_sig(-z, l1p)) & ~(unsigned)inv); }
            float gs[4], go[4];
#pragma unroll
            for (int q = 0; q < 4; ++q) { gs[q] = (lk[4 * q] + lk[4 * q + 1]) + (lk[4 * q + 2] + lk[4 * q + 3]);
                float x, y; xhalf_pair(gs[q], x, y); go[q] = hi ? x : y; }
            float suf[4];
            { float a = 0.f;
#pragma unroll
              for (int q = 3; q >= 0; --q) {
                  suf[q] = a + (hi ? 0.f : go[q]);
                  a += gs[q] + go[q]; }
              float p[16];
#pragma unroll
              for (int q = 0; q < 4; ++q) { float w = suf[q] + carry;
#pragma unroll
                  for (int i = 3; i >= 0; --i) { p[4 * q + i] = __expf(lb[4 * q + i] + w); w += lk[4 * q + i]; } }
              carry += a;
              asm volatile("s_waitcnt lgkmcnt(0)" ::: "memory");
              const bf16x8 pf0 = pack8(p), pf1 = pack8(p + 8);
#pragma unroll
              for (int dt = 0; dt < 2; ++dt) { const LAS unsigned char* vp = wl + vb + dt * 64;
                  const bf16x8 v0 = mk8(vtr(vp), vtr(vp + 8 * VSTR)), v1 = mk8(vtr(vp + 16 * VSTR), vtr(vp + 24 * VSTR));
                  Oa[dt] = __builtin_amdgcn_mfma_f32_32x32x16_bf16(v0, pf0, Oa[dt], 0, 0, 0);
                  Oa[dt] = __builtin_amdgcn_mfma_f32_32x32x16_bf16(v1, pf1, Oa[dt], 0, 0, 0); }
              asm volatile("s_waitcnt lgkmcnt(0)" ::: "memory"); }
#pragma unroll
            for (int i = 0; i < 4; ++i) { kf[i] = kn[i]; vr[i] = vn[i]; }
            if (__all(carry < -104.f)) break;
        }
#pragma unroll
        for (int dt = 0; dt < 2; ++dt)
#pragma unroll
            for (int gg = 0; gg < 4; ++gg) { u32x2 w; w.x = cvt_pk_bf16(Oa[dt][4 * gg], Oa[dt][4 * gg + 1]); w.y = cvt_pk_bf16(Oa[dt][4 * gg + 2], Oa[dt][4 * gg + 3]);
                *(u32x2*)(O + qrow * D + h * 64 + dt * 32 + 8 * gg + 4 * hi) = w; }
    }
}

__device__ __forceinline__ void dsa_mfma(const bf16_t* QB, const bf16_t* KB, const bf16_t* VB, const bf16_t* QI, const bf16_t* KI, const float* WI, const LAS float* brel, bf16_t* O, LAS unsigned char* lds, int vcu, int G, int tid) {
    const int lane = tid & 63, wave = __builtin_amdgcn_readfirstlane(tid >> 6), c = lane & 31, hi = lane >> 5, c16 = lane & 15, g4 = lane >> 4;
    constexpr int SCSTR = 2052, BM_OFF = 16 * SCSTR * 4, BMSTR = 65, VSTR = 192;
    LAS float* sc = (LAS float*)lds; LAS unsigned* bm = (LAS unsigned*)(lds + BM_OFF); LAS int* rowctr = (LAS int*)(lds + 154624);
    LAS unsigned char* wl = lds + wave * 6144;
    const int vb = vtr_base(lane, VSTR);
    const unsigned long long ltmask = (1ull << lane) - 1ull;
    for (int item = vcu; item < BATCH * 16; item += G) {
      const int b = item >> 4, sidx = item & 15;
      for (int u = 0; u < 2; ++u) {
        const int qb = u == 0 ? sidx : 31 - sidx, q0 = qb * 64;
        for (int sub = 0; sub < 4; ++sub) {
            const int q0s = q0 + 16 * sub;
            __syncthreads();
            if (tid == 0) *rowctr = 0;
            {
                const size_t qrow = (size_t)b * SEQ + q0s + c16;
                bf16x8 qf[4][2];
#pragma unroll
                for (int h = 0; h < 4; ++h)
#pragma unroll
                    for (int ks = 0; ks < 2; ++ks) qf[h][ks] = *(const bf16x8*)(QI + qrow * 256 + h * 64 + 32 * ks + 8 * g4);
                const f32x4 wi = *(const f32x4*)(WI + qrow * 4) * 0.125f;
                const int nt16 = (q0s >> 4) + 1, tq = q0s + c16;
                bf16x8 kf[2][2] = {}, kn[2][2] = {};
#pragma unroll
                for (int j = 0; j < 2; ++j) if (wave + 8 * j < nt16) {
#pragma unroll
                    for (int ks = 0; ks < 2; ++ks) kf[j][ks] = *(const bf16x8*)(KI + ((size_t)b * SEQ + (wave + 8 * j) * 16 + c16) * 64 + 32 * ks + 8 * g4); }
                for (int kt = wave; kt < nt16; kt += 16) {
#pragma unroll
                    for (int j = 0; j < 2; ++j) if (kt + 16 + 8 * j < nt16) {
#pragma unroll
                        for (int ks = 0; ks < 2; ++ks) kn[j][ks] = *(const bf16x8*)(KI + ((size_t)b * SEQ + (kt + 16 + 8 * j) * 16 + c16) * 64 + 32 * ks + 8 * g4); }
#pragma unroll
                    for (int j = 0; j < 2; ++j) if (kt + 8 * j < nt16) {
                        const int key0 = (kt + 8 * j) * 16;
                        f32x4 s4 = {0.f, 0.f, 0.f, 0.f};
#pragma unroll
                        for (int h = 0; h < 4; ++h) { float z = 0.f; asm volatile("" : "+v"(z)); f32x4 a = {z, z, z, z};
                            a = __builtin_amdgcn_mfma_f32_16x16x32_bf16(kf[j][0], qf[h][0], a, 0, 0, 0);
                            a = __builtin_amdgcn_mfma_f32_16x16x32_bf16(kf[j][1], qf[h][1], a, 0, 0, 0);
#pragma unroll
                            for (int r = 0; r < 4; ++r) s4[r] = __builtin_fmaf(wi[h], __builtin_fmaxf(a[r], 0.f), s4[r]); }
#pragma unroll
                        for (int r = 0; r < 4; ++r) if (key0 + 4 * g4 + r > tq) s4[r] = -INFINITY;
                        *(LAS f32x4*)(sc + c16 * SCSTR + key0 + 4 * g4) = s4; }
#pragma unroll
                    for (int j = 0; j < 2; ++j) { kf[j][0] = kn[j][0]; kf[j][1] = kn[j][1]; }
                }
            }
            __syncthreads();
            for (;;) {
                int ql = 0; if (lane == 0) ql = __atomic_fetch_add(rowctr, 1, __ATOMIC_RELAXED);
                ql = __builtin_amdgcn_readfirstlane(ql);
                if (ql >= 16) break;
                const int t = q0s + ql;
                float v[32];
#pragma unroll
                for (int r = 0; r < 32; ++r) { const int s = 64 * r + lane; const float x = sc[ql * SCSTR + s]; v[r] = (s <= t) ? x : -INFINITY; }
                const int nvalid = t + 1;
                float tau = -INFINITY; int need = 0;
#define DSA_CMP8(OP, b, thr, M) asm volatile(OP " %0, %9, %8\n\t" OP " %1, %10, %8\n\t" OP " %2, %11, %8\n\t" OP " %3, %12, %8\n\t" \
        OP " %4, %13, %8\n\t" OP " %5, %14, %8\n\t" OP " %6, %15, %8\n\t" OP " %7, %16, %8" \
        : "=s"(M[0]), "=s"(M[1]), "=s"(M[2]), "=s"(M[3]), "=s"(M[4]), "=s"(M[5]), "=s"(M[6]), "=s"(M[7]) \
        : "v"(thr), "v"(v[b]), "v"(v[b + 1]), "v"(v[b + 2]), "v"(v[b + 3]), "v"(v[b + 4]), "v"(v[b + 5]), "v"(v[b + 6]), "v"(v[b + 7]))
#define DSA_COUNT_OP(OP, dst, thr) do { const float _t = (thr); int _c = 0; _Pragma("unroll") for (int _g = 0; _g < 4; ++_g) { unsigned long long _m[8]; DSA_CMP8(OP, 8 * _g, _t, _m); \
        _c += (__popcll(_m[0]) + __popcll(_m[1])) + (__popcll(_m[2]) + __popcll(_m[3])) + ((__popcll(_m[4]) + __popcll(_m[5])) + (__popcll(_m[6]) + __popcll(_m[7]))); } dst = _c; } while (0)
#define DSA_COUNT_GT(dst, thr) DSA_COUNT_OP("v_cmp_gt_f32_e64", dst, thr)
#define DSA_COUNT_GE(dst, thr) DSA_COUNT_OP("v_cmp_ge_f32_e64", dst, thr)
#define DSA_F(cnt) (__builtin_amdgcn_logf((float)(cnt) + 0.5f) - 8.0f)
                if (nvalid > 256) {
                    float mx = v[0];
#pragma unroll
                    for (int r = 1; r < 32; ++r) mx = fmaxf(mx, v[r]);
                    mx = wave_max_dpp(mx);
                    float lo = 0.f, hi = mx, flo = 0.f, fhi = -9.0f; bool done = false, needmin = true;
                    if (mx > 0.f) { int cg; DSA_COUNT_GT(cg, 0.f);
                        if (cg == 256) { tau = 0.f; need = 0; done = true; needmin = false; }
                        else if (cg > 256) { lo = 0.f; flo = DSA_F(cg); needmin = false; }
                        else { int ce; DSA_COUNT_GE(ce, 0.f);
                            if (ce >= 256) { tau = 0.f; need = 256 - cg; done = true; needmin = false; }
                            else { hi = 0.f; fhi = DSA_F(cg); } } }
                    if (needmin) { float mn = INFINITY;
#pragma unroll
                        for (int r = 0; r < 32; ++r) mn = fminf(mn, (64 * r + lane <= t) ? v[r] : INFINITY);
                        mn = -wave_max(-mn, lane);
                        int cmin; DSA_COUNT_GT(cmin, mn);
                        if (cmin < 256) { tau = mn; need = 256 - cmin; done = true; }
                        else if (cmin == 256) { tau = mn; need = 0; done = true; }
                        else { lo = mn; flo = DSA_F(cmin); } }
                    {
                        int side = 0;
                        for (int it = 0; it < 24 && !done; ++it) {
                            float p = lo + (hi - lo) * (flo * __builtin_amdgcn_rcpf(flo - fhi));
                            if (!(p > lo && p < hi)) { p = lo + (hi - lo) * 0.5f;
                                if (!(p > lo && p < hi)) { tau = hi; int c; DSA_COUNT_GT(c, hi); need = 256 - c; done = true; break; } }
                            int c; DSA_COUNT_GT(c, p);
                            if (c == 256) { tau = p; need = 0; done = true; }
                            else if (c > 256) { lo = p; flo = DSA_F(c); if (side > 0) fhi *= 0.5f; side = 1; }
                            else { hi = p; fhi = DSA_F(c); if (side < 0) flo *= 0.5f; side = -1; } }
                        if (!done) {
                            auto okey = [](float f) { const unsigned u = __builtin_bit_cast(unsigned, f); return (u & 0x80000000u) ? ~u : (u | 0x80000000u); };
                            auto ofloat = [](unsigned k) { const unsigned u = (k & 0x80000000u) ? (k & 0x7FFFFFFFu) : ~k; return __builtin_bit_cast(float, u); };
                            unsigned kl = okey(lo), kh = okey(hi);
                            while (kh - kl > 1u) { const unsigned km = kl + ((kh - kl) >> 1); const float mid = ofloat(km); int c; DSA_COUNT_GT(c, mid);
                                if (c >= 256) kl = km; else kh = km; }
                            tau = ofloat(kh); int c; DSA_COUNT_GT(c, tau); need = 256 - c; if (need < 0) need = 0;
                        }
                    }
                }
#undef DSA_F
#undef DSA_COUNT_GE
#undef DSA_COUNT_OP
#undef DSA_COUNT_GT
#undef DSA_CMP8
                unsigned mylo = 0u, myhi = 0u;
                if (need == 0) {
#pragma unroll
                    for (int r = 0; r < 32; ++r) { const unsigned long long ms = __ballot(v[r] > tau); if (lane == r) { mylo = (unsigned)ms; myhi = (unsigned)(ms >> 32); } }
                } else {
                    int tie_seen = 0;
#pragma unroll
                    for (int r = 0; r < 32; ++r) {
                        const bool gt = v[r] > tau; const bool eq = (v[r] == tau);
                        const unsigned long long meq = __ballot(eq);
                        const bool sel = gt || (eq && (tie_seen + __popcll(meq & ltmask)) < need);
                        tie_seen += __popcll(meq);
                        const unsigned long long ms = __ballot(sel);
                        if (lane == r) { mylo = (unsigned)ms; myhi = (unsigned)(ms >> 32); }
                    }
                }
                if (lane < 32) { bm[(16 * sub + ql) * BMSTR + 2 * lane] = mylo; bm[(16 * sub + ql) * BMSTR + 2 * lane + 1] = myhi; }
            }
        }
        __syncthreads();
        {
            const int head = wave >> 1, qh = wave & 1, t = q0 + 32 * qh + c;
            const size_t qrow = (size_t)b * SEQ + t;
            bf16x8 qf[4];
#pragma unroll
            for (int ks = 0; ks < 4; ++ks) qf[ks] = *(const bf16x8*)(QB + qrow * 256 + head * 64 + 16 * ks + 8 * hi);
            f32x16 Oa[2];
#pragma unroll
            for (int dt = 0; dt < 2; ++dt) Oa[dt] = zero16();
            float m = -1e30f, l = 0.f;
            const float bfar = brel[127 * 12 + head] * LOG2E;
            const LAS float* bh = brel + head;
            const int ntile = 2 * qb + qh + 1;
            bf16x8 kf[4], kn[4] = {}; u32x4 vr[4], vn[4] = {};
            { const size_t krow0 = (size_t)b * SEQ;
#pragma unroll
              for (int ks = 0; ks < 4; ++ks) kf[ks] = *(const bf16x8*)(KB + (krow0 + c) * 64 + 16 * ks + 8 * hi);
#pragma unroll
              for (int i = 0; i < 4; ++i) { const int id = lane + 64 * i, row = id >> 3, ch = id & 7; vr[i] = *(const u32x4*)(VB + (krow0 + row) * 64 + ch * 8); } }
            for (int kt = 0; kt < ntile; ++kt) {
#pragma unroll
                for (int i = 0; i < 4; ++i) { const int id = lane + 64 * i, row = id >> 3, ch = id & 7; *(LAS u32x4*)(wl + row * VSTR + ch * 16) = vr[i]; }
                if (kt + 1 < ntile) { const size_t krow1 = (size_t)b * SEQ + (kt + 1) * 32;
#pragma unroll
                    for (int ks = 0; ks < 4; ++ks) kn[ks] = *(const bf16x8*)(KB + (krow1 + c) * 64 + 16 * ks + 8 * hi);
#pragma unroll
                    for (int i = 0; i < 4; ++i) { const int id = lane + 64 * i, row = id >> 3, ch = id & 7; vn[i] = *(const u32x4*)(VB + (krow1 + row) * 64 + ch * 8); } }
                const unsigned word = bm[(32 * qh + c) * BMSTR + kt] >> (4 * hi);
                f32x16 S = zero16();
#pragma unroll
                for (int ks = 0; ks < 4; ++ks) S = __builtin_amdgcn_mfma_f32_32x32x16_bf16(kf[ks], qf[ks], S, 0, 0, 0);
                const bool far = (32 * kt + 31 + 113 <= q0 + 32 * qh);
                const int rb = t - 32 * kt - 4 * hi;
                float sv[16], tm = -1e30f;
#pragma unroll
                for (int r = 0; r < 16; ++r) { const int cr = (r & 3) + 8 * (r >> 2);
                    float bias = bfar;
                    if (!far) { int rel = rb - cr; rel = rel < 0 ? 0 : (rel > 127 ? 127 : rel); bias = bh[rel * 12] * LOG2E; }
                    const float v = S[r] * (0.125f * LOG2E) + bias;
                    const unsigned selbit = (word >> cr) & 1u;
                    const float cap = __builtin_bit_cast(float, 0xFF800000u ^ (selbit << 31));
                    sv[r] = fminf(v, cap); tm = fmaxf(tm, sv[r]); }
                const float mn = fmaxf(m, xhalf_max(tm));
                const float f = __builtin_amdgcn_exp2f(m - mn); m = mn;
                float p[16], ps = 0.f;
#pragma unroll
                for (int r = 0; r < 16; ++r) { p[r] = __builtin_amdgcn_exp2f(sv[r] - mn); ps += p[r]; }
                l = l * f + ps;
#pragma unroll
                for (int dt = 0; dt < 2; ++dt) Oa[dt] *= f;
                const bf16x8 pf0 = pack8(p), pf1 = pack8(p + 8);
                asm volatile("s_waitcnt lgkmcnt(0)" ::: "memory");
#pragma unroll
                for (int dt = 0; dt < 2; ++dt) { const LAS unsigned char* vp = wl + vb + dt * 64;
                    const bf16x8 v0 = mk8(vtr(vp), vtr(vp + 8 * VSTR)), v1 = mk8(vtr(vp + 16 * VSTR), vtr(vp + 24 * VSTR));
                    Oa[dt] = __builtin_amdgcn_mfma_f32_32x32x16_bf16(v0, pf0, Oa[dt], 0, 0, 0);
                    Oa[dt] = __builtin_amdgcn_mfma_f32_32x32x16_bf16(v1, pf1, Oa[dt], 0, 0, 0); }
                asm volatile("s_waitcnt lgkmcnt(0)" ::: "memory");
#pragma unroll
                for (int i = 0; i < 4; ++i) { kf[i] = kn[i]; vr[i] = vn[i]; }
            }
            const float il = 1.0f / xhalf_sum(l);
#pragma unroll
            for (int dt = 0; dt < 2; ++dt)
#pragma unroll
                for (int gg = 0; gg < 4; ++gg) { u32x2 w; w.x = cvt_pk_bf16(Oa[dt][4 * gg] * il, Oa[dt][4 * gg + 1] * il); w.y = cvt_pk_bf16(Oa[dt][4 * gg + 2] * il, Oa[dt][4 * gg + 3] * il);
                    *(u32x2*)(O + qrow * D + 256 + head * 64 + dt * 32 + 8 * gg + 4 * hi) = w; }
        }
      }
    }
}
#ifndef EN_MASK
#define EN_MASK 0xFFFFFFFFu
#endif
#define EN(k) (((EN_MASK) >> (k)) & 1u)
#ifndef DUPMASK
#define DUPMASK 0u
#endif
#define NREP(k) ((((DUPMASK) >> (k)) & 1u) ? 2 : 1)
#ifndef USE_DSA_MFMA
#define USE_DSA_MFMA 1
#endif
#ifndef USE_X_MFMA
#define USE_X_MFMA 1
#endif
#ifndef USE_SWA_MFMA
#define USE_SWA_MFMA 1
#endif
#ifndef USE_SB_MFMA
#define USE_SB_MFMA 1
#endif
#ifndef MK_ONE_LAUNCH
#define MK_ONE_LAUNCH 1
#endif
enum { I_X = 0, I_MEM, I_RELB, I_NMIX, I_WIN, I_BGATE, I_QNDSA, I_KNDSA, I_QNSWA, I_KNSWA, I_SINKS, I_WPA, I_WPB, I_WPC, I_WOUT, I_NX, I_NMEM, I_WXQ, I_WXKV, I_WXO, I_QNX, I_KNX, I_NFFN, I_WGUD, I_WDND, I_WR, I_WGUM, I_WDNM, N_INPUTS };
struct Args { const float* in[N_INPUTS]; float* out; unsigned char* ws; int ph_lo, ph_hi, pad0, pad1; };
constexpr int N_PHASES = 1 + 16 * DEPTH;

template <class AP> __device__ __forceinline__ bool get_cvt_job(AP ap, bf16_t* Wb, int j, CvtJob& J) {
    J.dff = 0; J.kd0 = 0; J.map = 0;
    if (j < 16) { const int l = j >> 3, k = j & 7;
        switch (k) {
        case 0: J.W = ap->in[I_WIN] + (size_t)l * D * NIN; J.K = D; J.Nsrc = NIN; J.Ndst = NINP; J.ldd = D; J.map = 1; J.WT = Wb + WO_IN + (size_t)l * NINP * D; break;
        case 1: J.W = ap->in[I_WPA] + (size_t)l * 256 * D; J.K = 256; J.Nsrc = D; J.Ndst = D; J.ldd = D; J.kd0 = 0;   J.WT = Wb + WO_P + (size_t)l * D * D; break;
        case 2: J.W = ap->in[I_WPB] + (size_t)l * 256 * D; J.K = 256; J.Nsrc = D; J.Ndst = D; J.ldd = D; J.kd0 = 256; J.WT = Wb + WO_P + (size_t)l * D * D; break;
        case 3: J.W = ap->in[I_WPC] + (size_t)l * 512 * D; J.K = 512; J.Nsrc = D; J.Ndst = D; J.ldd = D; J.kd0 = 512; J.WT = Wb + WO_P + (size_t)l * D * D; break;
        case 4: J.W = ap->in[I_WOUT] + (size_t)l * D * D;  J.K = D; J.Nsrc = D; J.Ndst = D; J.ldd = D; J.WT = Wb + WO_OUT + (size_t)l * D * D; break;
        case 5: J.W = ap->in[I_WXQ] + (size_t)l * D * 512; J.K = D; J.Nsrc = 512; J.Ndst = 512; J.ldd = D; J.WT = Wb + WO_XQ + (size_t)l * 512 * D; break;
        case 6: J.W = ap->in[I_WXKV] + (size_t)l * D * D;  J.K = D; J.Nsrc = D; J.Ndst = D; J.ldd = D; J.WT = Wb + WO_XKV + (size_t)l * D * D; break;
        default: J.W = ap->in[I_WXO] + (size_t)l * 512 * D; J.K = 512; J.Nsrc = D; J.Ndst = D; J.ldd = 512; J.WT = Wb + WO_XO + (size_t)l * D * 512; break;
        }
        return true; }
    if (j == 16) { J.W = ap->in[I_WGUD]; J.K = D; J.Nsrc = 2 * DFF; J.Ndst = 2 * DFF; J.ldd = D; J.map = 2; J.dff = DFF; J.WT = Wb + WO_GUD; return true; }
    if (j == 17) { J.W = ap->in[I_WDND]; J.K = DFF; J.Nsrc = D; J.Ndst = D; J.ldd = DFF; J.WT = Wb + WO_DND; return true; }
    if (j < 26) { const int e = j - 18; J.W = ap->in[I_WGUM] + (size_t)e * D * 2 * DFFE; J.K = D; J.Nsrc = 2 * DFFE; J.Ndst = 2 * DFFE; J.ldd = D; J.map = 2; J.dff = DFFE; J.WT = Wb + WO_GUM + (size_t)e * 2 * DFFE * D; return true; }
    if (j < 34) { const int e = j - 26; J.W = ap->in[I_WDNM] + (size_t)e * DFFE * D; J.K = DFFE; J.Nsrc = D; J.Ndst = D; J.ldd = DFFE; J.WT = Wb + WO_DNM + (size_t)e * D * DFFE; return true; }
    return false;
}

typedef const __attribute__((address_space(4))) Args* KArgs;
#define KA() ({ KArgs _p = (KArgs)__builtin_amdgcn_kernarg_segment_ptr(); asm volatile("" : "+s"(_p)); _p; })
#define PHASE_VARS \
    KArgs A = KA(); unsigned char* const ws = A->ws; (void)ws; \
    int tid = threadIdx.x; asm volatile("" : "+v"(tid)); \
    const int lane = tid & 63, wave = __builtin_amdgcn_readfirstlane(tid >> 6); \
    int G = gridDim.x, bx = blockIdx.x; asm volatile("" : "+s"(G), "+s"(bx)); \
    const int vcu = (G % 8 == 0) ? (bx % 8) * (G / 8) + bx / 8 : bx; \
    const int gw = vcu * NWAVES + wave, ngw = G * NWAVES; \
    const int gtid = vcu * NTHR + tid, gthreads = G * NTHR; \
    (void)lane; (void)wave; (void)gw; (void)ngw; (void)gtid; (void)gthreads; (void)vcu;
#define WSP(T_, off) ((T_*)(ws + (off)))
#define XS ((bf16_t*)A->out)
#define LDXS (2 * D)

__global__ void __launch_bounds__(NTHR, 2) mega_fwd(Args args_unused) {
    extern __shared__ __attribute__((aligned(16))) unsigned char lds_raw[];
    LAS unsigned char* lds = (LAS unsigned char*)lds_raw;
    for (int u = threadIdx.x; u < (LDS_BYTES - LDSCTL_OFF) / 4; u += NTHR) ((LAS unsigned*)(lds + LDSCTL_OFF))[u] = 0u;
    __syncthreads();
#if MK_ONE_LAUNCH
    XcdBarrier bar;
    { KArgs A0 = KA(); bar = xcd_barrier_post((unsigned*)(A0->ws + WS_CTL) + CW_BAR, (volatile LAS unsigned*)(lds + MISC_OFF) + 8); }
#define GRID_BAR() xcd_barrier(bar)
#else
#define GRID_BAR() do { } while (0)
#endif
#if MK_ONE_LAUNCH
    constexpr int lo = 0, hi = N_PHASES;
#else
    int lo, hi; { KArgs A0 = KA(); lo = A0->ph_lo; hi = A0->ph_hi; }
#endif
#define IN(k) (lo <= (k) && (k) < hi)
#define SEAM(k) do { if (IN(k) && (k) + 1 < hi) GRID_BAR(); } while (0)

    if (EN(0) && IN(0)) {
        PHASE_VARS
        LAS float* scr = (LAS float*)(lds + wave * 16384);
        bf16_t* Wb = WSP(bf16_t, WS_W);
        for (int rep = 0; rep < NREP(2); ++rep) {
        int base = 0;
        for (int j = 0; j < 34; ++j) { CvtJob J; get_cvt_job(A, Wb, j, J);
            const int nitems = (J.K / 64) * (J.Ndst / 32);
            int first = (gw - base) % ngw; if (first < 0) first += ngw;
            for (int it = first; it < nitems; it += ngw) cvt_item(J, scr, it, lane);
            base += nitems; }
        }
        for (int l = 0; l < DEPTH; ++l)
            norm_rows<0, false>(A->in[I_MEM], D, A->in[I_NMEM] + l * D, WSP(bf16_t, WS_MEMN) + (size_t)l * TM * D, TM, nullptr, 0, nullptr, gw, ngw, lane);
    }
    SEAM(0);

    for (int l = 0; l < DEPTH; ++l) {
        const int P = 1 + 16 * l;
        if (EN(1) && IN(P + 0)) {
            PHASE_VARS
            for (int rep = 0; rep < NREP(3); ++rep)
              if (l == 0) norm_rows<4, false>(A->in[I_X], D, A->in[I_NMIX] + l * D, WSP(bf16_t, WS_XN), T, A->in[I_WIN] + (size_t)l * D * NIN + 1472, NIN, WSP(float, WS_WI), gw, ngw, lane);
              else norm_rows<4, true>(XS, LDXS, A->in[I_NMIX] + l * D, WSP(bf16_t, WS_XN), T, A->in[I_WIN] + (size_t)l * D * NIN + 1472, NIN, WSP(float, WS_WI), gw, ngw, lane);
        }
        SEAM(P + 0);
        if (IN(P + 1)) {
            if (EN(2)) { PHASE_VARS
              pg8::SchedG1 S; S.init(WSP(bf16_t, WS_XN), WSP(bf16_t, WS_W) + WO_IN + (size_t)l * NINP * D, G, bx);
              pg8::EpiG1 E{WSP(bf16_t, WS_QKV), WSP(bf16_t, WS_GATES), A->in[I_BGATE] + l * NGATE, A->in[I_QNDSA] + l * 64, A->in[I_KNDSA] + l * 64, A->in[I_QNSWA] + l * 64, A->in[I_KNSWA] + l * 64};
              for (int rep = 0; rep < NREP(4); ++rep) pg8::gemm_phase<pg8::EpiG1, pg8::SchedG1>(lds, S, E, D, D); }
            if (EN(3) && l == 0) { PHASE_VARS
              pg8::SchedMemKV S; S.G = G; S.c = (bx + G / 2) % G; S.A = (const char*)WSP(bf16_t, WS_MEMN); S.B0 = (const char*)(WSP(bf16_t, WS_W) + WO_XKV); S.B1 = (const char*)(WSP(bf16_t, WS_W) + WO_XKV + (size_t)D * D);
              pg8::EpiBf16 E{WSP(bf16_t, WS_MEMKV), D};
              pg8::gemm_phase<pg8::EpiBf16, pg8::SchedMemKV>(lds, S, E, D, D); }
        }
        SEAM(P + 1);
        if (IN(P + 2)) {
            { PHASE_VARS
              LAS float* brel = (LAS float*)(lds + 148480);
              for (int i = tid; i < 128 * 12; i += NTHR) { const int rel = i / 12, c = i % 12; brel[i] = A->in[I_RELB][t5_bucket(rel) * 12 + c]; }
              __syncthreads();
              if (EN(4) && l == 0) memk_norm(WSP(bf16_t, WS_MEMKV), A->in[I_KNX], gw, ngw, lane); }
            if (EN(7)) { PHASE_VARS
              bf16_t* QKV = WSP(bf16_t, WS_QKV);
              for (int rep = 0; rep < NREP(12); ++rep) dsa_mfma(QKV + (size_t)T * 768, QKV + (size_t)T * 1024, QKV + (size_t)T * 1088, QKV + (size_t)T * 1152, QKV + (size_t)T * 1408, WSP(float, WS_WI), (LAS float*)(lds + 148480), WSP(bf16_t, WS_O), lds, vcu, G, tid);
              __syncthreads(); }
            if (EN(6)) { PHASE_VARS
              bf16_t* QKV = WSP(bf16_t, WS_QKV);
              for (int rep = 0; rep < NREP(10); ++rep) { swa_mfma(QKV + (size_t)T * 1472, QKV + (size_t)T * 1984, QKV + (size_t)T * 2112, A->in[I_SINKS] + l * 8, (LAS float*)(lds + 148480), WSP(bf16_t, WS_O), lds, vcu, G, tid); __syncthreads(); } }
            if (EN(5)) { PHASE_VARS
              bf16_t* QKV = WSP(bf16_t, WS_QKV);
              for (int rep = 0; rep < NREP(11); ++rep) sb_mfma(QKV, QKV + (size_t)T * 256, QKV + (size_t)T * 512, WSP(bf16_t, WS_O), lds + 65536 + wave * 6144, gw, ngw, lane);
              __syncthreads(); }
        }
        SEAM(P + 2);
        if (EN(8) && IN(P + 3)) {
            PHASE_VARS
            pg8::SchedRot S; S.init(WSP(bf16_t, WS_O), WSP(bf16_t, WS_W) + WO_P + (size_t)l * D * D, T, D, D, D, D, G, bx);
            pg8::EpiMerge E{WSP(bf16_t, WS_GATES), WSP(bf16_t, WS_MB)};
            for (int rep = 0; rep < NREP(8); ++rep) pg8::gemm_phase<pg8::EpiMerge, pg8::SchedRot>(lds, S, E, D, D);
        }
        SEAM(P + 3);
        if (EN(9) && IN(P + 4)) {
            PHASE_VARS
            pg8::SchedPlain S; S.init(WSP(bf16_t, WS_MB), WSP(bf16_t, WS_W) + WO_OUT + (size_t)l * D * D, T, D, D, D, D, G, bx);
            pg8::EpiResidB E{(l == 0) ? (const void*)A->in[I_X] : (const void*)XS, (l == 0) ? D : LDXS, (l == 0) ? 1 : 0, XS, LDXS};
            pg8::gemm_phase<pg8::EpiResidB, pg8::SchedPlain>(lds, S, E, D, D);
        }
        SEAM(P + 4);
        if (EN(10) && IN(P + 5)) {
            PHASE_VARS
            for (int rep = 0; rep < NREP(3); ++rep) norm_rows<0, true>(XS, LDXS, A->in[I_NX] + l * D, WSP(bf16_t, WS_XN), T, nullptr, 0, nullptr, gw, ngw, lane);
        }
        SEAM(P + 5);
        if (EN(11) && IN(P + 6)) {
            PHASE_VARS
            pg8::SchedPlain S; S.init(WSP(bf16_t, WS_XN), WSP(bf16_t, WS_W) + WO_XQ + (size_t)l * 512 * D, T, 512, D, D, D, G, bx);
            pg8::EpiBf16 E{WSP(bf16_t, WS_QX), 512};
            pg8::gemm_phase<pg8::EpiBf16, pg8::SchedPlain>(lds, S, E, D, D);
        }
        SEAM(P + 6);
        if (EN(12) && IN(P + 7)) {
            PHASE_VARS
#if USE_X_MFMA
            for (int rep = 0; rep < NREP(1); ++rep)
            xattn_mfma(WSP(bf16_t, WS_QX), WSP(bf16_t, WS_MEMKV) + (size_t)l * TM * D, A->in[I_QNX] + l * 128, WSP(bf16_t, WS_OX), lds, vcu, G, tid);
            __syncthreads();
#else
            xattn_naive(WSP(bf16_t, WS_QX), WSP(bf16_t, WS_MEMKV) + (size_t)l * TM * D, A->in[I_QNX] + l * 128, WSP(bf16_t, WS_OX), gw, ngw, lane);
#endif
        }
        SEAM(P + 7);
        if (EN(13) && IN(P + 8)) {
            PHASE_VARS
            pg8::SchedPlain S; S.init(WSP(bf16_t, WS_OX), WSP(bf16_t, WS_W) + WO_XO + (size_t)l * D * 512, T, D, 512, 512, 512, G, bx);
            pg8::EpiResidB E{XS, LDXS, 0, XS, LDXS};
            pg8::gemm_phase<pg8::EpiResidB, pg8::SchedPlain>(lds, S, E, 512, 512);
        }
        SEAM(P + 8);
        if (l == 0) {
            if (EN(14) && IN(P + 9)) { PHASE_VARS
                for (int rep = 0; rep < NREP(3); ++rep) norm_rows<0, true>(XS, LDXS, A->in[I_NFFN] + l * D, WSP(bf16_t, WS_XN), T, nullptr, 0, nullptr, gw, ngw, lane); }
            SEAM(P + 9);
            if (EN(15) && IN(P + 10)) {
                PHASE_VARS
                pg8::SchedPlain S; S.init(WSP(bf16_t, WS_XN), WSP(bf16_t, WS_W) + WO_GUD, T, 2 * DFF, D, D, D, G, bx);
                pg8::EpiSwiglu E{WSP(bf16_t, WS_ACTD), DFF};
                for (int rep = 0; rep < NREP(7); ++rep) pg8::gemm_phase<pg8::EpiSwiglu, pg8::SchedPlain>(lds, S, E, D, D);
            }
            SEAM(P + 10);
            if (EN(16) && IN(P + 11)) {
                PHASE_VARS
                pg8::SchedPlain S; S.init(WSP(bf16_t, WS_ACTD), WSP(bf16_t, WS_W) + WO_DND, T, D, DFF, DFF, DFF, G, bx);
                pg8::EpiResidB E{XS, LDXS, 0, XS, LDXS};
                pg8::gemm_phase<pg8::EpiResidB, pg8::SchedPlain>(lds, S, E, DFF, DFF);
            }
            if (IN(P + 11) && P + 16 < hi) GRID_BAR();
        } else {
            if (EN(17) && IN(P + 9)) { PHASE_VARS
                norm_router(XS, LDXS, A->in[I_NFFN] + l * D, WSP(bf16_t, WS_XN), A->in[I_WR], WSP(int, WS_TOKE), WSP(float, WS_TOKG), WSP(int, WS_CNT), (LAS int*)(lds + 1024), vcu, G, wave, lane); }
            SEAM(P + 9);
            if (EN(18) && IN(P + 10)) { PHASE_VARS
                moe_assign(WSP(int, WS_CNT), WSP(int, WS_TOKE), WSP(float, WS_TOKG), WSP(int, WS_TOKS), WSP(int, WS_STOK), WSP(float, WS_SGATE), WSP(int, WS_PBASE), WSP(bf16_t, WS_XN), WSP(bf16_t, WS_AG), (LAS int*)(lds + 1024), vcu, G, wave, lane); }
            SEAM(P + 10);
            if (EN(19) && IN(P + 11)) {
                PHASE_VARS
                pg8::SchedMoe S; S.init(WSP(bf16_t, WS_AG), WSP(bf16_t, WS_W) + WO_GUM, WSP(int, WS_PBASE), 2 * DFFE, D, G, bx);
                pg8::EpiSwiglu E{WSP(bf16_t, WS_ACTM), DFFE};
                for (int rep = 0; rep < NREP(5); ++rep) pg8::gemm_phase<pg8::EpiSwiglu, pg8::SchedMoe>(lds, S, E, D, D);
            }
            SEAM(P + 11);
            if (EN(20) && IN(P + 12)) {
                PHASE_VARS
                int nfull, tail, sp; pg8::moe_tail_split(WSP(int, WS_PBASE)[NEXP] * (D / 256), G, DFFE / 64, nfull, tail, sp);
                { pg8::SchedMoeMain S; S.init(WSP(bf16_t, WS_ACTM), WSP(bf16_t, WS_W) + WO_DNM, WSP(int, WS_PBASE), D, DFFE, G, bx); S.nfull = nfull;
                  pg8::EpiMoeDown E{WSP(bf16_t, WS_Y), WSP(float, WS_SGATE)};
                  pg8::gemm_phase<pg8::EpiMoeDown, pg8::SchedMoeMain>(lds, S, E, DFFE, DFFE); }
                { pg8::SchedMoeTail S; S.init(WSP(bf16_t, WS_ACTM), WSP(bf16_t, WS_W) + WO_DNM, WSP(int, WS_PBASE), D, DFFE, G, bx); S.init_tail(nfull, tail, sp);
                  pg8::EpiMoePart E{WSP(float, WS_PART), WSP(int, WS_TMAP), S.pidx, tail};
                  pg8::gemm_phase<pg8::EpiMoePart, pg8::SchedMoeTail>(lds, S, E, DFFE, DFFE); }
            }
            SEAM(P + 12);
            if (EN(21) && IN(P + 13)) { PHASE_VARS
                int nfull, tail, sp; pg8::moe_tail_split(WSP(int, WS_PBASE)[NEXP] * (D / 256), G, DFFE / 64, nfull, tail, sp);
                moe_combine(A->out, XS, LDXS, WSP(bf16_t, WS_Y), WSP(int, WS_TOKS), WSP(float, WS_SGATE), WSP(float, WS_PART), WSP(int, WS_TMAP), tail, sp, gw, ngw, lane); }
        }
    }
#undef IN
#undef SEAM
}


#ifndef DBG_CHECK
#define DBG_CHECK 0
#endif
#if DBG_CHECK
__global__ void dbg_diff(const bf16_t* a, const bf16_t* b, int rows, int ld, int c0, int nc, double* acc, int slot) {
    double d = 0, e = 0;
    for (long i = (long)blockIdx.x * blockDim.x + threadIdx.x; i < (long)rows * nc; i += (long)gridDim.x * blockDim.x) { const long r = i / nc, c = c0 + i % nc; const float x = bf2f(a[r * ld + c]), y = bf2f(b[r * ld + c]); d += (double)(x - y) * (x - y); e += (double)x * x; }
    for (int o = 32; o >= 1; o >>= 1) { d += __shfl_xor(d, o); e += __shfl_xor(e, o); }
    if ((threadIdx.x & 63) == 0) { atomicAdd(acc + 2 * slot, d); atomicAdd(acc + 2 * slot + 1, e); }
}
__global__ void dbg_emit(float* out, const double* acc, int nslots) { double mx = 0; for (int s = 0; s < nslots; ++s) { const double r = acc[2 * s + 1] > 0 ? acc[2 * s] / acc[2 * s + 1] : 1.0; mx = r > mx ? r : mx; } out[0] += (float)(1e8 * mx); }
__global__ void __launch_bounds__(NTHR, 2) dbg_attn(Args args_unused) {
    extern __shared__ __attribute__((aligned(16))) unsigned char lds_raw[];
    LAS unsigned char* lds = (LAS unsigned char*)lds_raw;
    PHASE_VARS
    const int mode = A->ph_lo, l = A->ph_hi;
    bf16_t* QKV = WSP(bf16_t, WS_QKV); bf16_t* OB2 = WSP(bf16_t, WS_MB);
    if (mode == 0) { xattn_mfma(WSP(bf16_t, WS_QX), WSP(bf16_t, WS_MEMKV) + (size_t)l * TM * D, A->in[I_QNX] + l * 128, WSP(bf16_t, WS_OX) + (size_t)T * 512, lds, vcu, G, tid); }
    else {
        LAS float* brel = (LAS float*)(lds + 148480);
        for (int i = tid; i < 128 * 12; i += NTHR) { const int rel = i / 12, c = i % 12; brel[i] = A->in[I_RELB][t5_bucket(rel) * 12 + c]; }
        __syncthreads();
        if (mode == 1) swa_mfma(QKV + (size_t)T * 1472, QKV + (size_t)T * 1984, QKV + (size_t)T * 2112, A->in[I_SINKS] + l * 8, brel, OB2, lds, vcu, G, tid);
        else sb_mfma(QKV, QKV + (size_t)T * 256, QKV + (size_t)T * 512, OB2, lds + 65536 + wave * 6144, gw, ngw, lane);
    }
}
#endif
extern "C" void kernel_launch(void* const* d_in, const int* in_sizes, int n_in, void* d_out, int out_size, void* d_ws, size_t ws_size, hipStream_t stream) {
    static int grid = 0;
    if (grid == 0) {
        if (n_in != N_INPUTS || out_size != T * D || ws_size < WS_END) { fprintf(stderr, "kernel_launch: unexpected problem (n_in %d, out %d, ws %zu)\n", n_in, out_size, ws_size); grid = -1; return; }
        int dev = 0, cus = 0, per_cu = 0;
        if (hipGetDevice(&dev) != hipSuccess || hipDeviceGetAttribute(&cus, hipDeviceAttributeMultiprocessorCount, dev) != hipSuccess) { grid = -1; return; }
        if (hipFuncSetAttribute((const void*)mega_fwd, hipFuncAttributeMaxDynamicSharedMemorySize, LDS_BYTES) != hipSuccess) { fprintf(stderr, "kernel_launch: hipFuncSetAttribute failed\n"); grid = -1; return; }
        if (hipOccupancyMaxActiveBlocksPerMultiprocessor(&per_cu, (const void*)mega_fwd, NTHR, LDS_BYTES) != hipSuccess || per_cu < 1) fprintf(stderr, "kernel_launch: occupancy query says %d\n", per_cu);
        (void)hipGetLastError();
        grid = cus;
    }
    if (grid < 0) return;
    (void)hipMemsetAsync((char*)d_ws + WS_CTL, 0, CTL_ZERO_BYTES, stream);
    Args a{};
    for (int i = 0; i < N_INPUTS; ++i) a.in[i] = (const float*)d_in[i];
    a.out = (float*)d_out; a.ws = (unsigned char*)d_ws; a.pad0 = 0; a.pad1 = 0;
#if MK_ONE_LAUNCH
    a.ph_lo = 0; a.ph_hi = N_PHASES;
    hipLaunchKernelGGL(mega_fwd, dim3(grid), dim3(NTHR), LDS_BYTES, stream, a);
#else
    for (int p = 0; p < N_PHASES; ++p) {
        const int l = (p - 1) / 16, k = (p - 1) % 16;
        if (p > 0) { if (l == 0 && k > 11) continue; if (l == 1 && k > 13) continue; }
        a.ph_lo = p; a.ph_hi = p + 1;
        hipLaunchKernelGGL(mega_fwd, dim3(grid), dim3(NTHR), LDS_BYTES, stream, a);
#if DBG_CHECK
        { static bool attr2 = false; if (!attr2) { (void)hipFuncSetAttribute((const void*)dbg_attn, hipFuncAttributeMaxDynamicSharedMemorySize, LDS_BYTES); attr2 = true; }
          double* acc = (double*)((char*)d_ws + WS_CTL + 512 * 1024);
          if (p > 0 && k == 2) {
              Args a2 = a; a2.ph_hi = l;
              a2.ph_lo = 1; hipLaunchKernelGGL(dbg_attn, dim3(grid), dim3(NTHR), LDS_BYTES, stream, a2);
              hipLaunchKernelGGL(dbg_diff, dim3(1024), dim3(256), 0, stream, (const bf16_t*)((char*)d_ws + WS_O), (const bf16_t*)((char*)d_ws + WS_MB), T, D, 512, 512, acc, 3 * l + 0);
              a2.ph_lo = 2; hipLaunchKernelGGL(dbg_attn, dim3(grid), dim3(NTHR), LDS_BYTES, stream, a2);
              hipLaunchKernelGGL(dbg_diff, dim3(1024), dim3(256), 0, stream, (const bf16_t*)((char*)d_ws + WS_O), (const bf16_t*)((char*)d_ws + WS_MB), T, D, 0, 256, acc, 3 * l + 1); }
          if (p > 0 && k == 7) { Args a2 = a; a2.ph_hi = l; a2.ph_lo = 0; hipLaunchKernelGGL(dbg_attn, dim3(grid), dim3(NTHR), LDS_BYTES, stream, a2);
              hipLaunchKernelGGL(dbg_diff, dim3(1024), dim3(256), 0, stream, (const bf16_t*)((char*)d_ws + WS_OX), (const bf16_t*)((char*)d_ws + WS_OX) + (size_t)T * 512, T, 512, 0, 512, acc, 3 * l + 2); }
          if (p == N_PHASES - 3) hipLaunchKernelGGL(dbg_emit, dim3(1), dim3(1), 0, stream, (float*)d_out, (const double*)acc, DBG_NSLOT); }
#endif
    }
#endif
}
```

```cpp
#include <hip/hip_runtime.h>
#include <cstdio>
#include <cstdint>

#define LAS __attribute__((address_space(3)))
#define GAS __attribute__((address_space(1)))
typedef unsigned short bf16_t;
typedef short bf16x8 __attribute__((ext_vector_type(8)));
typedef float f32x4 __attribute__((ext_vector_type(4)));
typedef float f32x2 __attribute__((ext_vector_type(2)));
typedef unsigned u32x4 __attribute__((ext_vector_type(4)));
typedef unsigned u32x2 __attribute__((ext_vector_type(2)));

constexpr int D = 1024, BATCH = 16, SEQ = 2048, T = BATCH * SEQ, DEPTH = 2;
constexpr int NIN = 5316, NINP = 5376, NHEADC = 2304, NGATE = 3072;
constexpr int DFF = 2816, NEXP = 8, DFFE = 3584, NMEM = 256, TM = BATCH * NMEM;
constexpr int MAXSLOT = 67584;
constexpr float EPS = 1e-6f;

__device__ __forceinline__ unsigned f2bf(float f) { unsigned u = __builtin_bit_cast(unsigned, f); return (u + 0x7fffu + ((u >> 16) & 1u)) >> 16; }
__device__ __forceinline__ unsigned pk2(float lo, float hi) { return f2bf(lo) | (f2bf(hi) << 16); }
__device__ __forceinline__ float bf2f(unsigned short b) { return __builtin_bit_cast(float, ((unsigned)b) << 16); }
__device__ __forceinline__ float bflo(unsigned w) { return __builtin_bit_cast(float, w << 16); }
__device__ __forceinline__ float bfhi(unsigned w) { return __builtin_bit_cast(float, w & 0xffff0000u); }
typedef __bf16 bf16x2_t __attribute__((ext_vector_type(2)));
__device__ __forceinline__ unsigned cvt_pk_bf16(float lo, float hi) { const f32x2 v = {lo, hi}; const bf16x2_t b = __builtin_convertvector(v, bf16x2_t); return __builtin_bit_cast(unsigned, b); }

__device__ __forceinline__ float shx(float v, int o, int lane) { return __builtin_bit_cast(float, __builtin_amdgcn_ds_bpermute((lane ^ o) << 2, __builtin_bit_cast(int, v))); }
__device__ __forceinline__ int shdi(int v, int o, int lane) { return __builtin_amdgcn_ds_bpermute((lane + o) << 2, v); }

namespace pg8 {
constexpr int BM = 256, BK = 64, HALF = 128, HTB = HALF * BK * 2, STAGE_BYTES = 8 * HTB, NXCD = 8, WGM = 8;
__host__ __device__ __forceinline__ int lds_byte(int r, int c) { const int st = (r >> 4) * 2 + (c >> 5), rr = r & 15, cc = c & 31, ob = rr * 64 + cc * 2; return st * 1024 + (ob ^ (((ob >> 9) & 1) << 5)); }
__host__ __device__ __forceinline__ void stage_rc(int b, int& R, int& C) { const int st = b / 1024, sb = b % 1024, swz = sb ^ (((sb >> 9) & 1) << 5); R = (st >> 1) * 16 + swz / 64; C = (st & 1) * 32 + (swz % 64) / 2; }
__host__ __device__ __forceinline__ int perm32(int rho) { const int n = rho >> 4, i = rho & 15; return 8 * (i >> 2) + 4 * n + (i & 3); }

struct Unit { int pm, pn, g, s; };

struct TileOrder {
    int nM, nN, nwg;
    __device__ __forceinline__ void init(int nM_, int nN_) { nM = nM_; nN = nN_; nwg = nM * nN; }
    __device__ __forceinline__ bool get(long L, int& pm, int& pn) const {
        if (L >= nwg) return false;
        int wgid = (int)L; { const int q = nwg / NXCD, r = nwg % NXCD, xcd = wgid % NXCD, off = wgid / NXCD; wgid = (xcd < r ? xcd * (q + 1) : r * (q + 1) + (xcd - r) * q) + off; }
        const int nig = WGM * nN, gid = wgid / nig, fm = gid * WGM, gsz = (nM - fm) < WGM ? (nM - fm) : WGM;
        pm = fm + ((wgid % nig) % gsz); pn = (wgid % nig) / gsz; return true;
    }
};

__device__ __forceinline__ float ssq8(bf16x8 v, float s) {
    const u32x4 w = __builtin_bit_cast(u32x4, v);
    asm("v_dot2c_f32_bf16 %0, %1, %1\n\tv_dot2c_f32_bf16 %0, %2, %2\n\tv_dot2c_f32_bf16 %0, %3, %3\n\tv_dot2c_f32_bf16 %0, %4, %4" : "+v"(s) : "v"(w.x), "v"(w.y), "v"(w.z), "v"(w.w));
    return s; }
template <class Epi, class Sched>
__device__ __forceinline__ void gemm_phase(LAS unsigned char* lds, const Sched& S, const Epi& E, const int lda, const int ldb) {
    int tid = threadIdx.x; asm volatile("" : "+v"(tid));
    const int wid = __builtin_amdgcn_readfirstlane(tid >> 6), lane = tid & 63, wr = wid >> 2, wc = wid & 3, fr = lane & 15, fq = lane >> 4;
    unsigned voffA[2], voffB[2];
#pragma unroll
    for (int i = 0; i < 2; ++i) { int R, C; stage_rc(tid * 16 + i * 8192, R, C); const int Rb = Epi::PERM ? ((R & ~31) + perm32(R & 31)) : R;
        voffA[i] = (unsigned)(R * lda + C) * 2u; voffB[i] = (unsigned)(Rb * ldb + C) * 2u; }
    const size_t kstep = (size_t)(BK * 2);
    const size_t hstepA = (size_t)HALF * lda * 2, hstepB = (size_t)HALF * ldb * 2;
    const unsigned ldsw = (unsigned)wid * 1024u;
    const int aoff = lds_byte(wr * 64 + fr, fq * 8), boff = lds_byte(wc * 32 + fr, fq * 8);
#define PG8_SA(b, h) (((b) * 2 + (h)) * HTB)
#define PG8_SB(b, h) ((4 + (b) * 2 + (h)) * HTB)
#define PG8_STAGE(bufoff, gbase, voff) do { _Pragma("unroll") for (int _i = 0; _i < 2; ++_i) \
        __builtin_amdgcn_global_load_lds((const unsigned*)((const char*)(gbase) + (voff)[_i]), (LAS unsigned*)(lds + (bufoff) + ldsw + _i * 8192), 16, 0, 0); } while (0)
#define PG8_LDA(dst, b, h) do { _Pragma("unroll") for (int m = 0; m < 4; ++m) _Pragma("unroll") for (int k = 0; k < 2; ++k) dst[m][k] = *(const LAS bf16x8*)(lds + PG8_SA(b, h) + aoff + m * 2048 + k * 1024); } while (0)
#define PG8_LDB(dst, b, h) do { _Pragma("unroll") for (int n = 0; n < 2; ++n) _Pragma("unroll") for (int k = 0; k < 2; ++k) dst[n][k] = *(const LAS bf16x8*)(lds + PG8_SB(b, h) + boff + n * 2048 + k * 1024); } while (0)
#define PG8_MMA(ai, bj, At, Bt) do { __builtin_amdgcn_s_setprio(1); _Pragma("unroll") for (int m = 0; m < 4; ++m) _Pragma("unroll") for (int n = 0; n < 2; ++n) _Pragma("unroll") for (int k = 0; k < 2; ++k) \
        acc[ai][bj][m][n] = __builtin_amdgcn_mfma_f32_16x16x32_bf16(Bt[n][k], At[m][k], acc[ai][bj][m][n], 0, 0, 0); __builtin_amdgcn_s_setprio(0); } while (0)
#define PG8_WAIT_V(n) asm volatile("s_waitcnt vmcnt(" #n ")" ::: "memory")
#define PG8_WAIT_L(n) asm volatile("s_waitcnt lgkmcnt(" #n ")" ::: "memory")
#define PG8_BAR __builtin_amdgcn_s_barrier()
#define PG8_SCHED __builtin_amdgcn_sched_barrier(0)
    Unit cur, nxt; int ui = 0;
    if (!S.next(0, cur)) return;
    f32x4 acc[2][2][4][2];
#pragma unroll
    for (int a = 0; a < 2; ++a)
#pragma unroll
        for (int b = 0; b < 2; ++b)
#pragma unroll
            for (int m = 0; m < 4; ++m)
#pragma unroll
                for (int n = 0; n < 2; ++n) acc[a][b][m][n] = (f32x4){0.f, 0.f, 0.f, 0.f};
    bf16x8 At[4][2], B0[2][2], B1[2][2];
    float ssq[2][4] = {{0.f, 0.f, 0.f, 0.f}, {0.f, 0.f, 0.f, 0.f}};
#define PG8_SSQ(h) do { if constexpr (Epi::SSQ) { _Pragma("unroll") for (int m = 0; m < 4; ++m) ssq[h][m] = ssq8(At[m][1], ssq8(At[m][0], ssq[h][m])); } } while (0)
    const char* cA = S.a_ptr(cur); const char* cB = S.b_ptr(cur); int nt = S.nt(cur);
    int rot = 0; if constexpr (Sched::ROT) rot = cur.g;
    { const char* fA = cA + (size_t)rot * kstep; const char* fB = cB + (size_t)rot * kstep;
      PG8_STAGE(PG8_SB(0, 0), fB, voffB); PG8_STAGE(PG8_SB(0, 1), fB + hstepB, voffB); PG8_STAGE(PG8_SA(0, 0), fA, voffA); PG8_STAGE(PG8_SA(0, 1), fA + hstepA, voffA);
      if (wr == 1) PG8_BAR;
      PG8_WAIT_V(2); PG8_BAR;
      PG8_STAGE(PG8_SB(1, 0), fB + kstep, voffB); PG8_STAGE(PG8_SA(1, 0), fA + kstep, voffA); PG8_STAGE(PG8_SB(1, 1), fB + hstepB + kstep, voffB);
      PG8_WAIT_V(6); PG8_BAR; }
    for (;;) {
        const bool has_next = S.next(ui + 1, nxt);
        const char* nA = cA; const char* nB = cB; int nnt = nt, nrot = rot;
        if (has_next) { nA = S.a_ptr(nxt); nB = S.b_ptr(nxt); nnt = S.nt(nxt); if constexpr (Sched::ROT) nrot = nxt.g; }
        nA += (size_t)nrot * kstep; nB += (size_t)nrot * kstep;
        for (int t = 0; t < nt; t += 2) {
            if constexpr (Epi::HOOK) { if (E.hook_at(cur, t)) E.mid(acc, cur, t, wr, wc, fr, fq); }
            const bool last = (t == nt - 2);
            const int k0 = Sched::ROT ? ((t + rot) & (nt - 1)) : t, k2 = Sched::ROT ? ((t + 2 + rot) & (nt - 1)) : t + 2;
            const char* a1 = cA + (size_t)(k0 + 1) * kstep;
            const char* a2 = last ? nA : cA + (size_t)k2 * kstep; const char* b2 = last ? nB : cB + (size_t)k2 * kstep;
            const char* a3 = a2 + kstep; const char* b3 = b2 + kstep;
            PG8_LDB(B0, 0, 0); PG8_LDB(B1, 0, 1); PG8_SCHED; PG8_LDA(At, 0, 0); PG8_STAGE(PG8_SA(1, 1), a1 + hstepA, voffA);
            PG8_WAIT_V(8); PG8_WAIT_L(0); PG8_BAR; PG8_MMA(0, 0, At, B0); PG8_MMA(0, 1, At, B1); PG8_SSQ(0); PG8_BAR; PG8_SCHED;
            PG8_LDA(At, 0, 1); PG8_STAGE(PG8_SB(0, 0), b2, voffB); PG8_STAGE(PG8_SB(0, 1), b2 + hstepB, voffB); PG8_STAGE(PG8_SA(0, 0), a2, voffA);
            PG8_WAIT_V(8); PG8_WAIT_L(0); PG8_BAR; PG8_MMA(1, 0, At, B0); PG8_MMA(1, 1, At, B1); PG8_SSQ(1); PG8_BAR; PG8_SCHED;
            PG8_LDB(B0, 1, 0); PG8_LDB(B1, 1, 1); PG8_SCHED; PG8_LDA(At, 1, 0); PG8_STAGE(PG8_SA(0, 1), a2 + hstepA, voffA);
            PG8_WAIT_V(8); PG8_WAIT_L(0); PG8_BAR; PG8_MMA(0, 0, At, B0); PG8_MMA(0, 1, At, B1); PG8_SSQ(0); PG8_BAR; PG8_SCHED;
            PG8_LDA(At, 1, 1); PG8_STAGE(PG8_SB(1, 0), b3, voffB); PG8_STAGE(PG8_SB(1, 1), b3 + hstepB, voffB); PG8_STAGE(PG8_SA(1, 0), a3, voffA);
            PG8_WAIT_V(8); PG8_WAIT_L(0); PG8_BAR; PG8_MMA(1, 0, At, B0); PG8_MMA(1, 1, At, B1); PG8_SSQ(1); PG8_BAR; PG8_SCHED;
        }
        if (wr == 0) PG8_BAR;
        if constexpr (Epi::SSQ) { E.rows(acc, cur, wr, wc, fr, fq, ssq);
#pragma unroll
            for (int h = 0; h < 2; ++h)
#pragma unroll
                for (int m = 0; m < 4; ++m) ssq[h][m] = 0.f; }
        else E(acc, cur, wr, wc, fr, fq);
        if (!has_next) break;
#pragma unroll
        for (int a = 0; a < 2; ++a)
#pragma unroll
            for (int b = 0; b < 2; ++b)
#pragma unroll
                for (int m = 0; m < 4; ++m)
#pragma unroll
                    for (int n = 0; n < 2; ++n) acc[a][b][m][n] = (f32x4){0.f, 0.f, 0.f, 0.f};
        cur = nxt; cA = nA - (size_t)nrot * kstep; cB = nB - (size_t)nrot * kstep; nt = nnt; rot = nrot; ++ui;
        if (wr == 1) PG8_BAR;
    }
    PG8_WAIT_V(0);
    PG8_BAR;
#undef PG8_SSQ
#undef PG8_SA
#undef PG8_SB
#undef PG8_STAGE
#undef PG8_LDA
#undef PG8_LDB
#undef PG8_MMA
#undef PG8_WAIT_V
#undef PG8_WAIT_L
#undef PG8_BAR
#undef PG8_SCHED
}
}
namespace pg8 {
__device__ __forceinline__ u32x2 gate_pack8(const f32x4& v0, const f32x4& v1) {
    int a = 0, b = 0;
    a = __builtin_amdgcn_cvt_pk_fp8_f32(v0[0], v0[1], a, false); a = __builtin_amdgcn_cvt_pk_fp8_f32(v0[2], v0[3], a, true);
    b = __builtin_amdgcn_cvt_pk_fp8_f32(v1[0], v1[1], b, false); b = __builtin_amdgcn_cvt_pk_fp8_f32(v1[2], v1[3], b, true);
    return u32x2{(unsigned)a, (unsigned)b}; }
__device__ __forceinline__ void gate_unpack8(const u32x2 w, f32x4& v0, f32x4& v1) {
    const f32x2 p0 = __builtin_amdgcn_cvt_pk_f32_fp8((int)w.x, false), p1 = __builtin_amdgcn_cvt_pk_f32_fp8((int)w.x, true);
    const f32x2 p2 = __builtin_amdgcn_cvt_pk_f32_fp8((int)w.y, false), p3 = __builtin_amdgcn_cvt_pk_f32_fp8((int)w.y, true);
    v0 = f32x4{p0.x, p0.y, p1.x, p1.y}; v1 = f32x4{p2.x, p2.y, p3.x, p3.y}; }
__device__ __forceinline__ float gate_den(float s) { float d = 1.0f + __builtin_amdgcn_exp2f(s); asm("v_min_f32 %0, 0x5368d4a5, %1" : "=v"(d) : "v"(d)); return d; }
__device__ __forceinline__ float sigmoidf_(float x) { return __builtin_amdgcn_rcpf(1.0f + __builtin_amdgcn_exp2f(x * -1.4426950408889634f)); }

struct SchedPlain {
    static constexpr bool ROT = false;
    TileOrder to; int G, c, ntk; const char* A; const char* B; size_t astep, bstep;
    __device__ __forceinline__ void init(const void* A_, const void* B_, int M, int N, int K, int lda, int ldb, int G_, int c_) {
        to.init(M / BM, N / BM); G = G_; c = c_; ntk = K / BK; A = (const char*)A_; B = (const char*)B_; astep = (size_t)BM * lda * 2; bstep = (size_t)BM * ldb * 2; }
    __device__ __forceinline__ bool next(int i, Unit& u) const { u.g = 0; return to.get((long)i * G + c, u.pm, u.pn); }
    __device__ __forceinline__ const char* a_ptr(const Unit& u) const { return A + (size_t)u.pm * astep; }
    __device__ __forceinline__ const char* b_ptr(const Unit& u) const { return B + (size_t)u.pn * bstep; }
    __device__ __forceinline__ int nt(const Unit&) const { return ntk; }
};
struct SchedRot : SchedPlain {
    static constexpr bool ROT = true;
    __device__ __forceinline__ bool next(int i, Unit& u) const { u.g = ((c >> 3) & 1) ? 8 : 0; return to.get((long)i * G + c, u.pm, u.pn); }
};
struct SchedG1 {
    static constexpr bool ROT = false;
    TileOrder th, tg; int G, c; const char* A; const char* B;
    __device__ __forceinline__ void init(const void* A_, const void* B_, int G_, int c_) { th.init(T / BM, 9); tg.init(T / BM, 12); G = G_; c = c_; A = (const char*)A_; B = (const char*)B_; }
    __device__ __forceinline__ bool next(int i, Unit& u) const { const long L = (long)i * G + c; u.g = 0;
        if (L < th.nwg) return th.get(L, u.pm, u.pn);
        if (!tg.get(L - th.nwg, u.pm, u.pn)) return false; u.pn += 9; return true; }
    __device__ __forceinline__ const char* a_ptr(const Unit& u) const { return A + (size_t)u.pm * BM * D * 2; }
    __device__ __forceinline__ const char* b_ptr(const Unit& u) const { return B + (size_t)u.pn * BM * D * 2; }
    __device__ __forceinline__ int nt(const Unit&) const { return D / BK; }
};
struct SchedMerge {
    static constexpr bool ROT = false;
    TileOrder to; int G, c; const char* A; const char* B;
    __device__ __forceinline__ void init(const void* A_, const void* B_, int G_, int c_) { to.init(T / BM, D / BM); G = G_; c = c_; A = (const char*)A_; B = (const char*)B_; }
    __device__ __forceinline__ bool next(int i, Unit& u) const { const int ti = i / 3; u.g = i - 3 * ti; return to.get((long)ti * G + c, u.pm, u.pn); }
    __device__ __forceinline__ int koff(int g) const { return g == 0 ? 0 : (g == 1 ? 256 : 512); }
    __device__ __forceinline__ const char* a_ptr(const Unit& u) const { return A + ((size_t)u.pm * BM * D + koff(u.g)) * 2; }
    __device__ __forceinline__ const char* b_ptr(const Unit& u) const { return B + ((size_t)u.pn * BM * D + koff(u.g)) * 2; }
    __device__ __forceinline__ int nt(const Unit& u) const { return u.g == 2 ? 8 : 4; }
};
struct SchedMemKV {
    static constexpr bool ROT = false;
    int G, c; const char* A; const char* B0; const char* B1;
    __device__ __forceinline__ bool next(int i, Unit& u) const { const long L = (long)i * G + c; if (L >= 128) return false; u.pm = (int)L >> 2; u.pn = (int)L & 3; u.g = u.pm >> 4; return true; }
    __device__ __forceinline__ const char* a_ptr(const Unit& u) const { return A + (size_t)u.pm * BM * D * 2; }
    __device__ __forceinline__ const char* b_ptr(const Unit& u) const { return (u.g ? B1 : B0) + (size_t)u.pn * BM * D * 2; }
    __device__ __forceinline__ int nt(const Unit&) const { return D / BK; }
};
struct SchedMoe {
    static constexpr bool ROT = false;
    TileOrder to; int G, c, ntk; const char* A; const char* B; size_t astep, bstep, estep; int pb[NEXP + 1];
    __device__ __forceinline__ void init(const void* A_, const void* B_, const int* pbase, int N, int K, int G_, int c_) {
#pragma unroll
        for (int e = 0; e <= NEXP; ++e) pb[e] = pbase[e];
        to.init(pb[NEXP], N / BM); G = G_; c = c_; ntk = K / BK; A = (const char*)A_; B = (const char*)B_; astep = (size_t)BM * K * 2; bstep = (size_t)BM * K * 2; estep = (size_t)N * K * 2; }
    __device__ __forceinline__ bool next(int i, Unit& u) const { if (!to.get((long)i * G + c, u.pm, u.pn)) return false; int e = 0;
#pragma unroll
        for (int j = 1; j < NEXP; ++j) e += (u.pm >= pb[j]) ? 1 : 0;
        u.g = e; return true; }
    __device__ __forceinline__ const char* a_ptr(const Unit& u) const { return A + (size_t)u.pm * astep; }
    __device__ __forceinline__ const char* b_ptr(const Unit& u) const { return B + (size_t)u.g * estep + (size_t)u.pn * bstep; }
    __device__ __forceinline__ int nt(const Unit&) const { return ntk; }
};

__device__ __forceinline__ void moe_tail_split(int U, int G, int ntk, int& nfull, int& tail, int& S) {
    nfull = U / G; tail = U - nfull * G; S = 1;
    const int cand[4] = {14, 7, 4, 2};
#pragma unroll
    for (int i = 3; i >= 0; --i) { const int s = cand[i]; if (tail > 0 && ntk % s == 0 && ((ntk / s) & 1) == 0 && ntk / s >= 4 && s * tail <= G) S = s; }
}
struct SchedMoeMain : SchedMoe {
    int nfull;
    __device__ __forceinline__ bool next(int i, Unit& u) const { if (i >= nfull) return false; return SchedMoe::next(i, u); }
};
struct SchedMoeTail : SchedMoe {
    int valid, pidx, ntp; long L; size_t koff;
    __device__ __forceinline__ void init_tail(int nfull, int tail, int S) {
        valid = (tail > 0 && c < S * tail) ? 1 : 0; const int tl = tail > 0 ? tail : 1, j = c % tl, s = c / tl;
        pidx = s * tl + j; ntp = ntk / S; L = (long)nfull * G + j; koff = (size_t)s * (size_t)ntp * (size_t)(BK * 2); }
    __device__ __forceinline__ bool next(int i, Unit& u) const { if (i != 0 || !valid) return false; if (!to.get(L, u.pm, u.pn)) return false; int e = 0;
#pragma unroll
        for (int j = 1; j < NEXP; ++j) e += (u.pm >= pb[j]) ? 1 : 0;
        u.g = e; return true; }
    __device__ __forceinline__ const char* a_ptr(const Unit& u) const { return A + (size_t)u.pm * astep + koff; }
    __device__ __forceinline__ const char* b_ptr(const Unit& u) const { return B + (size_t)u.g * estep + (size_t)u.pn * bstep + koff; }
    __device__ __forceinline__ int nt(const Unit&) const { return ntp; }
};

struct EpiResid {
    static constexpr bool PERM = false, HOOK = false, SSQ = false;
    const float* base; float* out; int ldc;
    __device__ __forceinline__ void operator()(const f32x4 (&acc)[2][2][4][2], const Unit& u, int wr, int wc, int fr, int fq) const {
        const int row0 = u.pm * BM + wr * 64 + fr, col0 = u.pn * BM + wc * 32 + 4 * fq;
#pragma unroll
        for (int ai = 0; ai < 2; ++ai)
#pragma unroll
            for (int m = 0; m < 4; ++m) { const size_t off = (size_t)(row0 + ai * HALF + m * 16) * ldc + col0;
                f32x4 bs[2][2];
#pragma unroll
                for (int bj = 0; bj < 2; ++bj)
#pragma unroll
                    for (int n = 0; n < 2; ++n) bs[bj][n] = *(const f32x4*)(base + off + bj * HALF + n * 16);
#pragma unroll
                for (int bj = 0; bj < 2; ++bj)
#pragma unroll
                    for (int n = 0; n < 2; ++n) *(f32x4*)(out + off + bj * HALF + n * 16) = bs[bj][n] + acc[ai][bj][m][n];
                asm volatile("" ::: "memory"); }
    }
};
struct EpiResidB {
    static constexpr bool PERM = true, HOOK = false, SSQ = false;
    const void* base; int ldb; int base_f32; bf16_t* out; int ldc;
    __device__ __forceinline__ void operator()(const f32x4 (&acc)[2][2][4][2], const Unit& u, int wr, int wc, int fr, int fq) const {
        const int row0 = u.pm * BM + wr * 64 + fr, col0 = u.pn * BM + wc * 32 + 8 * fq;
#pragma unroll
        for (int ai = 0; ai < 2; ++ai)
#pragma unroll
            for (int m = 0; m < 4; ++m) { const int row = row0 + ai * HALF + m * 16;
                f32x4 bs[2][2];
                if (base_f32) {
#pragma unroll
                    for (int bj = 0; bj < 2; ++bj) { const float* bp = (const float*)base + (size_t)row * ldb + col0 + bj * HALF; bs[bj][0] = *(const f32x4*)bp; bs[bj][1] = *(const f32x4*)(bp + 4); }
                } else {
#pragma unroll
                    for (int bj = 0; bj < 2; ++bj) { const u32x4 w = *(const u32x4*)((const bf16_t*)base + (size_t)row * ldb + col0 + bj * HALF);
                        bs[bj][0] = f32x4{bflo(w.x), bfhi(w.x), bflo(w.y), bfhi(w.y)}; bs[bj][1] = f32x4{bflo(w.z), bfhi(w.z), bflo(w.w), bfhi(w.w)}; }
                }
                bf16_t* rowp = out + (size_t)row * ldc + col0;
#pragma unroll
                for (int bj = 0; bj < 2; ++bj) { const f32x4 v0 = acc[ai][bj][m][0] + bs[bj][0], v1 = acc[ai][bj][m][1] + bs[bj][1];
                    u32x4 w; w.x = cvt_pk_bf16(v0[0], v0[1]); w.y = cvt_pk_bf16(v0[2], v0[3]); w.z = cvt_pk_bf16(v1[0], v1[1]); w.w = cvt_pk_bf16(v1[2], v1[3]);
                    *(u32x4*)(rowp + bj * HALF) = w; }
                asm volatile("" ::: "memory"); }
    }
};
struct EpiBf16 {
    static constexpr bool PERM = true, HOOK = false, SSQ = false;
    bf16_t* O; int ldc;
    __device__ __forceinline__ void operator()(const f32x4 (&acc)[2][2][4][2], const Unit& u, int wr, int wc, int fr, int fq) const {
        const int row0 = u.pm * BM + wr * 64 + fr, col0 = u.pn * BM + wc * 32 + 8 * fq;
#pragma unroll
        for (int ai = 0; ai < 2; ++ai)
#pragma unroll
            for (int m = 0; m < 4; ++m) { bf16_t* rowp = O + (size_t)(row0 + ai * HALF + m * 16) * ldc + col0;
#pragma unroll
                for (int bj = 0; bj < 2; ++bj) { const f32x4 v0 = acc[ai][bj][m][0], v1 = acc[ai][bj][m][1];
                    u32x4 w; w.x = cvt_pk_bf16(v0[0], v0[1]); w.y = cvt_pk_bf16(v0[2], v0[3]); w.z = cvt_pk_bf16(v1[0], v1[1]); w.w = cvt_pk_bf16(v1[2], v1[3]);
                    *(u32x4*)(rowp + bj * HALF) = w; } }
    }
};
struct EpiBf16Rs {
    static constexpr bool PERM = true, HOOK = false, SSQ = true;
    bf16_t* O; int ldc; float inv_k;
    __device__ __forceinline__ void rows(const f32x4 (&acc)[2][2][4][2], const Unit& u, int wr, int wc, int fr, int fq, const float (&ssq)[2][4]) const {
        const int row0 = u.pm * BM + wr * 64 + fr, col0 = u.pn * BM + wc * 32 + 8 * fq, lane = fr + 16 * fq;
#pragma unroll
        for (int ai = 0; ai < 2; ++ai)
#pragma unroll
            for (int m = 0; m < 4; ++m) { float s = ssq[ai][m]; s += shx(s, 16, lane); s += shx(s, 32, lane);
                const float r = __builtin_amdgcn_rsqf(s * inv_k + EPS);
                bf16_t* rowp = O + (size_t)(row0 + ai * HALF + m * 16) * ldc + col0;
#pragma unroll
                for (int bj = 0; bj < 2; ++bj) { const f32x4 v0 = acc[ai][bj][m][0] * r, v1 = acc[ai][bj][m][1] * r;
                    u32x4 w; w.x = cvt_pk_bf16(v0[0], v0[1]); w.y = cvt_pk_bf16(v0[2], v0[3]); w.z = cvt_pk_bf16(v1[0], v1[1]); w.w = cvt_pk_bf16(v1[2], v1[3]);
                    *(u32x4*)(rowp + bj * HALF) = w; } }
    }
};
struct EpiG1 {
    static constexpr bool PERM = true, HOOK = false, SSQ = false;
    bf16_t* qkv;
    unsigned char* gates;
    const float* bgate;
    const float *gn_qb, *gn_kb, *gn_qc, *gn_kc;
    __device__ __forceinline__ void operator()(const f32x4 (&acc)[2][2][4][2], const Unit& u, int wr, int wc, int fr, int fq) const {
        const int row0 = u.pm * BM + wr * 64 + fr;
        if (u.pn < 9) {
            const int slot = 4 * u.pn + wc;
            if (slot == 35) return;
            size_t dst; int pitch, head; const float* gn = nullptr;
            if (slot < 4)       { dst = 0;                        pitch = 256; head = slot; }
            else if (slot < 8)  { dst = (size_t)T * 256;          pitch = 256; head = slot - 4; }
            else if (slot < 12) { dst = (size_t)T * 512;          pitch = 256; head = slot - 8; }
            else if (slot < 16) { dst = (size_t)T * 768;          pitch = 256; head = slot - 12; gn = gn_qb; }
            else if (slot == 16){ dst = (size_t)T * 1024;         pitch = 64;  head = 0; gn = gn_kb; }
            else if (slot == 17){ dst = (size_t)T * 1088;         pitch = 64;  head = 0; }
            else if (slot < 22) { dst = (size_t)T * 1152;         pitch = 256; head = slot - 18; }
            else if (slot == 22){ dst = (size_t)T * 1408;         pitch = 64;  head = 0; }
            else if (slot < 31) { dst = (size_t)T * 1472;         pitch = 512; head = slot - 23; gn = gn_qc; }
            else if (slot < 33) { dst = (size_t)T * 1984;         pitch = 128; head = slot - 31; gn = gn_kc; }
            else                { dst = (size_t)T * 2112;         pitch = 128; head = slot - 33; }
            bf16_t* base = qkv + dst + head * 64 + 8 * fq;
            f32x4 g0[2], g1[2];
            if (gn) {
#pragma unroll
                for (int bj = 0; bj < 2; ++bj) { g0[bj] = *(const f32x4*)(gn + 32 * bj + 8 * fq); g1[bj] = *(const f32x4*)(gn + 32 * bj + 8 * fq + 4); }
            }
#pragma unroll
            for (int ai = 0; ai < 2; ++ai)
#pragma unroll
                for (int m = 0; m < 4; ++m) {
                    f32x4 v[2][2];
#pragma unroll
                    for (int bj = 0; bj < 2; ++bj) { v[bj][0] = acc[ai][bj][m][0]; v[bj][1] = acc[ai][bj][m][1]; }
                    if (gn) {
                        float ss = 0.f;
#pragma unroll
                        for (int bj = 0; bj < 2; ++bj)
#pragma unroll
                            for (int n = 0; n < 2; ++n) ss += (v[bj][n][0] * v[bj][n][0] + v[bj][n][1] * v[bj][n][1]) + (v[bj][n][2] * v[bj][n][2] + v[bj][n][3] * v[bj][n][3]);
                        ss += shx(ss, 16, 16 * fq + fr); ss += shx(ss, 32, 16 * fq + fr);
                        const float r = __builtin_amdgcn_rsqf(ss * (1.0f / 64.0f) + EPS);
#pragma unroll
                        for (int bj = 0; bj < 2; ++bj) { v[bj][0] = v[bj][0] * r * g0[bj]; v[bj][1] = v[bj][1] * r * g1[bj]; }
                    }
                    bf16_t* rowp = base + (size_t)(row0 + ai * HALF + m * 16) * pitch;
#pragma unroll
                    for (int bj = 0; bj < 2; ++bj) { u32x4 w; w.x = cvt_pk_bf16(v[bj][0][0], v[bj][0][1]); w.y = cvt_pk_bf16(v[bj][0][2], v[bj][0][3]); w.z = cvt_pk_bf16(v[bj][1][0], v[bj][1][1]); w.w = cvt_pk_bf16(v[bj][1][2], v[bj][1][3]);
                        *(u32x4*)(rowp + 32 * bj) = w; }
                }
        } else {
            const int col0 = (u.pn - 9) * BM + wc * 32 + 8 * fq;
            f32x4 bv[2][2];
#pragma unroll
            for (int bj = 0; bj < 2; ++bj)
#pragma unroll
                for (int n = 0; n < 2; ++n) bv[bj][n] = *(const f32x4*)(bgate + col0 + bj * HALF + 4 * n);
#pragma unroll
            for (int ai = 0; ai < 2; ++ai)
#pragma unroll
                for (int m = 0; m < 4; ++m) { unsigned char* rowp = gates + ((size_t)u.pm * 12 + (u.pn - 9)) * 65536 + (size_t)((ai * 4 + m) * 2) * 4096 + (wr * 4 + wc) * 512 + (fr + 16 * fq) * 8;
#pragma unroll
                    for (int bj = 0; bj < 2; ++bj) { f32x4 v0 = acc[ai][bj][m][0] + bv[bj][0], v1 = acc[ai][bj][m][1] + bv[bj][1];
                        v0 *= -1.4426950408889634f; v1 *= -1.4426950408889634f;
#pragma unroll
                        for (int j = 0; j < 4; ++j) { v0[j] = __builtin_amdgcn_fmed3f(v0[j], -64.0f, 64.0f); v1[j] = __builtin_amdgcn_fmed3f(v1[j], -64.0f, 64.0f); }
                        *(u32x2*)(rowp + bj * 4096) = gate_pack8(v0, v1); } }
        }
    }
};
struct EpiMerge {
    static constexpr bool PERM = true, HOOK = true, SSQ = false;
    const unsigned char* gates; bf16_t* mb;
    __device__ __forceinline__ bool hook_at(const Unit& u, int t) const { return u.g == 0 ? (t == 4 || t == 8) : (t == 8 || t == 12); }
    __device__ __forceinline__ void mid(f32x4 (&acc)[2][2][4][2], const Unit& u, int t, int wr, int wc, int fr, int fq) const {
        int row0 = u.pm * BM + wr * 64 + fr; const int col0 = u.pn * BM + wc * 32 + 8 * fq;
        const int ga = (u.g == 0) ? ((t == 4) ? 0 : D) : ((t == 8) ? 2 * D : 0), gb = (u.g == 0) ? ga + D : ((t == 8) ? 0 : D);
        asm volatile("" : "+v"(row0));
        u32x2 na[2][2][2], nb[2][2][2];
        const unsigned char* gbase = gates + ((size_t)u.pm * 12 + u.pn) * 65536 + (wr * 4 + wc) * 512 + (fr + 16 * fq) * 8 + (row0 & 0);
        const size_t ta = (size_t)(ga / D) * 4 * 65536, tb = (size_t)(gb / D) * 4 * 65536;
#define MERGE_ISSUE(q) do { _Pragma("unroll") for (int mi = 0; mi < 2; ++mi) { const unsigned char* gp = gbase + (size_t)(((((q) >> 1) * 4 + 2 * ((q) & 1) + mi)) * 2) * 4096; \
            _Pragma("unroll") for (int bj = 0; bj < 2; ++bj) { na[(q) & 1][mi][bj] = *(const u32x2*)(gp + ta + bj * 4096); nb[(q) & 1][mi][bj] = *(const u32x2*)(gp + tb + bj * 4096); } } } while (0)
        MERGE_ISSUE(0); MERGE_ISSUE(1);
#pragma unroll
        for (int q = 0; q < 4; ++q) {
            asm volatile("" ::: "memory");
            const int ai = q >> 1;
#pragma unroll
            for (int mi = 0; mi < 2; ++mi) { const int m = 2 * (q & 1) + mi;
#pragma unroll
                for (int bj = 0; bj < 2; ++bj) { f32x4 sa0, sa1, sb0, sb1; gate_unpack8(na[q & 1][mi][bj], sa0, sa1); gate_unpack8(nb[q & 1][mi][bj], sb0, sb1);
                    f32x4 r0, r1;
#pragma unroll
                    for (int j = 0; j < 4; ++j) { r0[j] = gate_den(sb0[j]) * __builtin_amdgcn_rcpf(gate_den(sa0[j])); r1[j] = gate_den(sb1[j]) * __builtin_amdgcn_rcpf(gate_den(sa1[j])); }
                    acc[ai][bj][m][0] *= r0; acc[ai][bj][m][1] *= r1; } }
            asm volatile("" ::: "memory");
            if (q == 0) MERGE_ISSUE(2);
            if (q == 1) MERGE_ISSUE(3);
        }
#undef MERGE_ISSUE
    }
    __device__ __forceinline__ void operator()(const f32x4 (&acc)[2][2][4][2], const Unit& u, int wr, int wc, int fr, int fq) const {
        const int row0 = u.pm * BM + wr * 64 + fr, col0 = u.pn * BM + wc * 32 + 8 * fq, gfin = (u.g == 0) ? 2 * D : D;
#pragma unroll
        for (int ai = 0; ai < 2; ++ai)
#pragma unroll
            for (int m = 0; m < 4; ++m) { const size_t row = (size_t)(row0 + ai * HALF + m * 16);
#pragma unroll
                for (int bj = 0; bj < 2; ++bj) { const int col = col0 + bj * HALF;
                    f32x4 s0, s1; gate_unpack8(*(const u32x2*)(gates + ((size_t)u.pm * 12 + (gfin / D) * 4 + u.pn) * 65536 + (size_t)(((ai * 4 + m) * 2 + bj)) * 4096 + (wr * 4 + wc) * 512 + (fr + 16 * fq) * 8), s0, s1);
                    f32x4 v0 = acc[ai][bj][m][0], v1 = acc[ai][bj][m][1];
#pragma unroll
                    for (int j = 0; j < 4; ++j) { v0[j] *= __builtin_amdgcn_rcpf(gate_den(s0[j])); v1[j] *= __builtin_amdgcn_rcpf(gate_den(s1[j])); }
                    u32x4 w; w.x = cvt_pk_bf16(v0[0], v0[1]); w.y = cvt_pk_bf16(v0[2], v0[3]); w.z = cvt_pk_bf16(v1[0], v1[1]); w.w = cvt_pk_bf16(v1[2], v1[3]);
                    *(u32x4*)(mb + row * D + col) = w; } }
    }
};
struct EpiSwiglu {
    static constexpr bool PERM = true, HOOK = false, SSQ = false;
    bf16_t* O; int ldc;
    __device__ __forceinline__ void operator()(const f32x4 (&acc)[2][2][4][2], const Unit& u, int wr, int wc, int fr, int fq) const {
        const int row0 = u.pm * BM + wr * 64 + fr, col0 = u.pn * HALF + wc * 32 + 8 * fq;
#pragma unroll
        for (int ai = 0; ai < 2; ++ai)
#pragma unroll
            for (int m = 0; m < 4; ++m) { bf16_t* rowp = O + (size_t)(row0 + ai * HALF + m * 16) * ldc + col0;
                f32x4 r[2];
#pragma unroll
                for (int n = 0; n < 2; ++n) { const f32x4 g = acc[ai][0][m][n], uu = acc[ai][1][m][n];
#pragma unroll
                    for (int j = 0; j < 4; ++j) r[n][j] = g[j] * sigmoidf_(g[j]) * uu[j]; }
                u32x4 w; w.x = cvt_pk_bf16(r[0][0], r[0][1]); w.y = cvt_pk_bf16(r[0][2], r[0][3]); w.z = cvt_pk_bf16(r[1][0], r[1][1]); w.w = cvt_pk_bf16(r[1][2], r[1][3]);
                *(u32x4*)rowp = w; }
    }
};
struct EpiMoeDown {
    static constexpr bool PERM = true, HOOK = false, SSQ = false;
    bf16_t* Y; const float* sgate;
    __device__ __forceinline__ void operator()(const f32x4 (&acc)[2][2][4][2], const Unit& u, int wr, int wc, int fr, int fq) const {
        const int row0 = u.pm * BM + wr * 64 + fr, col0 = u.pn * BM + wc * 32 + 8 * fq;
#pragma unroll
        for (int ai = 0; ai < 2; ++ai)
#pragma unroll
            for (int m = 0; m < 4; ++m) { const int row = row0 + ai * HALF + m * 16; const float gt = sgate[row]; bf16_t* rowp = Y + (size_t)row * D + col0;
#pragma unroll
                for (int bj = 0; bj < 2; ++bj) { const f32x4 v0 = acc[ai][bj][m][0] * gt, v1 = acc[ai][bj][m][1] * gt;
                    u32x4 w; w.x = cvt_pk_bf16(v0[0], v0[1]); w.y = cvt_pk_bf16(v0[2], v0[3]); w.z = cvt_pk_bf16(v1[0], v1[1]); w.w = cvt_pk_bf16(v1[2], v1[3]);
                    *(u32x4*)(rowp + bj * HALF) = w; } }
    }
};
struct EpiMoePart {
    static constexpr bool PERM = true, HOOK = false, SSQ = false;
    float* part; int* tmap; int pidx, tail;
    __device__ __forceinline__ void operator()(const f32x4 (&acc)[2][2][4][2], const Unit& u, int wr, int wc, int fr, int fq) const {
        float* pt = part + (size_t)pidx * (BM * BM) + (size_t)(wr * 64 + fr) * BM + wc * 32 + 8 * fq;
#pragma unroll
        for (int ai = 0; ai < 2; ++ai)
#pragma unroll
            for (int m = 0; m < 4; ++m)
#pragma unroll
                for (int bj = 0; bj < 2; ++bj) { float* p = pt + (size_t)(ai * HALF + m * 16) * BM + bj * HALF; *(f32x4*)p = acc[ai][bj][m][0]; *(f32x4*)(p + 4) = acc[ai][bj][m][1]; }
        if (pidx < tail && wr == 0 && wc == 0 && fr == 0 && fq == 0) tmap[u.pm * 4 + u.pn] = pidx + 1;
    }
};
}
constexpr size_t MiB = 1u << 20;
constexpr size_t WS_CTL = 0, CTL_ZERO_BYTES = 1 * MiB;
constexpr size_t WS_SMALL = 1 * MiB;
constexpr size_t WS_WI    = WS_SMALL;
constexpr size_t WS_TOKE  = WS_SMALL + 512 * 1024;
constexpr size_t WS_TOKG  = WS_TOKE + 256 * 1024;
constexpr size_t WS_TOKS  = WS_TOKG + 256 * 1024;
constexpr size_t WS_STOK  = WS_TOKS + 256 * 1024;
constexpr size_t WS_SGATE = WS_STOK + 272 * 1024;
constexpr size_t WS_CNT   = WS_SGATE + 272 * 1024;
constexpr size_t WS_PBASE = WS_CNT + 8192;
static_assert(WS_PBASE + 64 <= 4 * MiB, "small arrays");
constexpr size_t WS_W = 4 * MiB;
constexpr size_t WO_IN   = 0;
constexpr size_t WO_P    = WO_IN + 2ull * NINP * D;
constexpr size_t WO_OUT  = WO_P + 2ull * D * D;
constexpr size_t WO_XQ   = WO_OUT + 2ull * D * D;
constexpr size_t WO_XKV  = WO_XQ + 2ull * 512 * D;
constexpr size_t WO_XO   = WO_XKV + 2ull * D * D;
constexpr size_t WO_GUD  = WO_XO + 2ull * D * 512;
constexpr size_t WO_DND  = WO_GUD + 2ull * DFF * D;
constexpr size_t WO_GUM  = WO_DND + (size_t)D * DFF;
constexpr size_t WO_DNM  = WO_GUM + 8ull * 2 * DFFE * D;
constexpr size_t WO_END  = WO_DNM + 8ull * D * DFFE;
static_assert(WO_END * 2 <= 224 * MiB, "weights fit");
constexpr size_t WS_XN   = 228 * MiB;
constexpr size_t WS_PART = WS_XN;
constexpr size_t WS_TMAP = WS_CTL + 64 * 1024;
constexpr size_t WS_R    = 292 * MiB;
constexpr size_t WS_QKV  = WS_R;
constexpr size_t WS_GATES= WS_R + 144 * MiB;
constexpr size_t WS_O    = WS_R + 336 * MiB;
constexpr size_t WS_MB   = WS_R + 400 * MiB;
constexpr size_t WS_MEMN = WS_R + 464 * MiB;
constexpr size_t WS_MEMKV= WS_R + 480 * MiB;
constexpr size_t WS_MF   = WS_R;
constexpr size_t WS_QX   = WS_R;
constexpr size_t WS_OX   = WS_R + 32 * MiB;
constexpr size_t WS_ACTD = WS_R;
constexpr size_t WS_AG   = WS_R;
constexpr size_t WS_Y    = WS_R;
constexpr size_t WS_ACTM = WS_R + 132 * MiB;
constexpr size_t WS_END  = WS_ACTM + 462 * MiB;
static_assert((size_t)MAXSLOT * DFFE * 2 <= 462 * MiB && (size_t)MAXSLOT * D * 2 <= 132 * MiB, "moe buffers");

constexpr int CW_BAR = 4096;

constexpr int RING_BYTES = 131072;
constexpr int LDS_BYTES = 163840;
constexpr int LDSCTL_OFF = LDS_BYTES - 1024, MISC_OFF = LDSCTL_OFF + 320;
constexpr int NWAVES = 8, NTHR = 512;

typedef GAS unsigned gu32;
#define RLX_AGENT __ATOMIC_RELAXED, __HIP_MEMORY_SCOPE_AGENT
#define LDS_WAIT() asm volatile("s_waitcnt lgkmcnt(0)" ::: "memory")
#define VM_WAIT() asm volatile("s_waitcnt vmcnt(0)" ::: "memory")

#define XB_TMO      128
#define XB_XCNT(j)  (256  + 64 * (j))
#define XB_XSUB(j)  (1280 + 64 * (j))
#define XB_XGEN(j)  (2304 + 64 * (j))
#define XB_TOP      3328
#define XB_TOPGEN   3392
#define XCD_BAR_WORDS 3456
#define XB_SPIN_CAP (1u << 22)

__device__ __forceinline__ unsigned xb_ld(unsigned* p)              { return __hip_atomic_load(p, __ATOMIC_RELAXED, __HIP_MEMORY_SCOPE_AGENT); }
__device__ __forceinline__ unsigned xb_add(unsigned* p, unsigned v) { return __hip_atomic_fetch_add(p, v, __ATOMIC_RELAXED, __HIP_MEMORY_SCOPE_AGENT); }
__device__ __forceinline__ unsigned xb_xcc_id() { return (unsigned)__builtin_amdgcn_s_getreg((3 << 11) | 20) & 0xFu; }
#define XB_SPIN(cond, bar) do { unsigned _sp = 0; while (cond) { __builtin_amdgcn_s_sleep(1); \
    if ((++_sp & 255u) == 0u) { if (xb_ld(&(bar)[XB_TMO])) break; if (_sp > XB_SPIN_CAP) { atomicAdd(&(bar)[XB_TMO], 1u); break; } } } } while (0)

struct XcdBarrier { unsigned* bar; unsigned x; volatile LAS unsigned* st; };

__device__ __forceinline__ XcdBarrier xcd_barrier_post(unsigned* bar, volatile LAS unsigned* st) {
    XcdBarrier b; b.bar = bar; b.x = xb_xcc_id(); b.st = st;
    if (threadIdx.x == 0) (void)xb_add(&bar[XB_XCNT(b.x)], 1u);
    return b;
}
__device__ __forceinline__ void xcd_barrier_complete(unsigned* bar, unsigned x, unsigned& nloc, unsigned& nx) {
    const unsigned G = gridDim.x * gridDim.y * gridDim.z;
    unsigned sum, cnt, mine, sp = 0u;
    for (;;) {
        sum = 0u; cnt = 0u; mine = 0u;
#pragma unroll
        for (unsigned j = 0; j < 16; ++j) { const unsigned c = xb_ld(&bar[XB_XCNT(j)]); sum += c; cnt += (c > 0u) ? 1u : 0u; mine = (j == x) ? c : mine; }
        if (sum == G) break;
        __builtin_amdgcn_s_sleep(1);
        if ((++sp & 255u) == 0u) { if (xb_ld(&bar[XB_TMO])) break; if (sp > XB_SPIN_CAP) { atomicAdd(&bar[XB_TMO], 1u); break; } }
    }
    nloc = mine > 0u ? mine : 1u; nx = cnt > 0u ? cnt : 1u;
}
__device__ __forceinline__ void xcd_barrier_impl(unsigned* bar0, unsigned x, volatile LAS unsigned* st) {
    asm volatile("" : "+s"(bar0), "+s"(x));
    XcdBarrier b; b.bar = bar0; b.x = x; b.st = st;
    asm volatile("s_waitcnt vmcnt(0)" ::: "memory");
    __syncthreads();
    if (threadIdx.x == 0) {
        unsigned* bar = b.bar;
        __builtin_amdgcn_s_waitcnt(0);
        unsigned nloc = b.st[0], nx = b.st[1];
        if (nloc == 0u) { xcd_barrier_complete(bar, b.x, nloc, nx); b.st[0] = nloc; b.st[1] = nx; }
        const unsigned old = xb_add(&bar[XB_XSUB(b.x)], 1u);
        const unsigned gen = old / nloc;
        if (old + 1u == (gen + 1u) * nloc) {
            __builtin_amdgcn_fence(__ATOMIC_RELEASE, "agent");
            asm volatile("s_waitcnt vmcnt(0)" ::: "memory");
            const unsigned og = xb_add(&bar[XB_TOP], 1u);
            const unsigned tg = og / nx;
            if (og + 1u == (tg + 1u) * nx) xb_add(&bar[XB_TOPGEN], 1u);
            else XB_SPIN(xb_ld(&bar[XB_TOPGEN]) == tg, bar);
            __builtin_amdgcn_fence(__ATOMIC_ACQUIRE, "agent");
            xb_add(&bar[XB_XGEN(b.x)], 1u);
            asm volatile("s_waitcnt vmcnt(0)" ::: "memory");
        } else {
            XB_SPIN(xb_ld(&bar[XB_XGEN(b.x)]) == gen, bar);
            __builtin_amdgcn_fence(__ATOMIC_ACQUIRE, "agent");
            asm volatile("s_waitcnt vmcnt(0)" ::: "memory");
        }
    }
    __syncthreads();
}
__device__ __forceinline__ void xcd_barrier(const XcdBarrier& b) { xcd_barrier_impl(b.bar, b.x, b.st); }

__device__ __forceinline__ float wave_sum(float v, int lane) {
#pragma unroll
    for (int o = 1; o < 64; o <<= 1) v += shx(v, o, lane);
    return v;
}
template <int CTRL> __device__ __forceinline__ float dpp_max_step(float x) { const int xi = __builtin_bit_cast(int, x); return fmaxf(x, __builtin_bit_cast(float, __builtin_amdgcn_update_dpp(xi, xi, CTRL, 0xf, 0xf, false))); }
__device__ __forceinline__ float wave_max_dpp(float x) {
    x = dpp_max_step<0x111>(x); x = dpp_max_step<0x112>(x); x = dpp_max_step<0x114>(x); x = dpp_max_step<0x118>(x); x = dpp_max_step<0x142>(x); x = dpp_max_step<0x143>(x);
    return __builtin_bit_cast(float, __builtin_amdgcn_readlane(__builtin_bit_cast(int, x), 63));
}
template <int CTRL, int RM, int BM> __device__ __forceinline__ float dpp_get0(float x) { return __builtin_bit_cast(float, __builtin_amdgcn_update_dpp(0, __builtin_bit_cast(int, x), CTRL, RM, BM, false)); }
__device__ __forceinline__ float wave_sum_dpp(float x) {
    float s = x + dpp_get0<0x111, 0xf, 0xf>(x); s += dpp_get0<0x112, 0xf, 0xf>(x); s += dpp_get0<0x113, 0xf, 0xf>(x);
    s += dpp_get0<0x114, 0xf, 0xe>(s); s += dpp_get0<0x118, 0xf, 0xc>(s); s += dpp_get0<0x142, 0xa, 0xf>(s); s += dpp_get0<0x143, 0xc, 0xf>(s);
    return __builtin_bit_cast(float, __builtin_amdgcn_readlane(__builtin_bit_cast(int, s), 63));
}
__device__ __forceinline__ float wave_max(float v, int lane) {
#pragma unroll
    for (int o = 1; o < 64; o <<= 1) v = fmaxf(v, shx(v, o, lane));
    return v;
}
__device__ __forceinline__ int t5_bucket(int rel) {
    const int n = rel < 0 ? 0 : rel;
    if (n < 16) return n;
    const int large = 16 + (int)(logf((float)n / 16.0f) / 2.0794415416798357f * 16.0f);
    return large < 31 ? large : 31;
}

struct CvtJob { const float* W; int K, Nsrc, Ndst, ldd, kd0, map, dff; bf16_t* WT; const float* ks; };
__device__ __forceinline__ int cvt_srccol(const CvtJob& J, int n0) {
    if (J.map == 0) return n0;
    if (J.map == 1) {
        if (n0 >= NHEADC) return 2244 + (n0 - NHEADC);
        const int pn = n0 >> 8, p = n0 & 255, bj = p >> 7, wc = (p & 127) >> 5, slot = 4 * pn + wc;
        if (slot == 35) return -1;
        return (slot < 23 ? 64 * slot : 1476 + 64 * (slot - 23)) + 32 * bj;
    }
    const int pn = n0 >> 8, p = n0 & 255, bj = p >> 7, w = p & 127;
    return bj * J.dff + 128 * pn + w;
}
__device__ __forceinline__ void cvt_item(const CvtJob& J, LAS float* scr, int item, int lane) {
    const int nblk = J.Ndst / 32, kb = item / nblk, nb = item % nblk, k0 = 64 * kb, n0 = 32 * nb;
    const int sc = cvt_srccol(J, n0);
    if (sc >= 0) {
#pragma unroll
        for (int i = 0; i < 16; ++i) { const int kk = 2 * i + (lane >> 5); scr[kk * 33 + (lane & 31)] = J.W[(size_t)(k0 + kk) * J.Nsrc + sc + (lane & 31)]; }
        asm volatile("" ::: "memory");
#pragma unroll
        for (int i = 16; i < 32; ++i) { const int kk = 2 * i + (lane >> 5); scr[kk * 33 + (lane & 31)] = J.W[(size_t)(k0 + kk) * J.Nsrc + sc + (lane & 31)]; }
        if (J.ks) {
            LDS_WAIT(); asm volatile("" ::: "memory");
#pragma unroll
            for (int i = 0; i < 32; ++i) { const int kk = 2 * i + (lane >> 5); scr[kk * 33 + (lane & 31)] *= J.ks[k0 + kk]; } }
    } else {
#pragma unroll 8
        for (int i = 0; i < 32; ++i) { const int kk = 2 * i + (lane >> 5); scr[kk * 33 + (lane & 31)] = 0.f; }
    }
    LDS_WAIT(); asm volatile("" ::: "memory");
    const int c = lane & 7;
#pragma unroll
    for (int j = 0; j < 4; ++j) { const int n = (lane >> 3) + 8 * j; const LAS float* s = scr + (8 * c) * 33 + n;
        u32x4 o; o.x = pk2(s[0 * 33], s[1 * 33]); o.y = pk2(s[2 * 33], s[3 * 33]); o.z = pk2(s[4 * 33], s[5 * 33]); o.w = pk2(s[6 * 33], s[7 * 33]);
        *(GAS u32x4*)(J.WT + (size_t)(n0 + n) * J.ldd + J.kd0 + k0 + 8 * c) = o; }
    LDS_WAIT(); asm volatile("" ::: "memory");
}
template <bool XB> __device__ __forceinline__ f32x4 ldx4(const void* x, size_t off) {
    if (XB) { const u32x2 w = *(const u32x2*)((const bf16_t*)x + off); return f32x4{bflo(w.x), bfhi(w.x), bflo(w.y), bfhi(w.y)}; }
    return *(const f32x4*)((const float*)x + off);
}
template <int NP, bool XB>
__device__ __forceinline__ void norm_rows(const void* x, int ldx, const float* gain, bf16_t* xn, int nrows, const float* Wp, int ldwp, float* proj, int gw, int ngw, int lane) {
    f32x4 g[4];
#pragma unroll
    for (int j = 0; j < 4; ++j) g[j] = *(const f32x4*)(gain + 4 * lane + 256 * j);
    float wp[NP > 0 ? NP : 1][16];
    if (NP > 0) {
#pragma unroll
        for (int j = 0; j < 4; ++j)
#pragma unroll
            for (int i = 0; i < 4; ++i)
#pragma unroll
                for (int c = 0; c < NP; ++c) wp[c][4 * j + i] = Wp[(size_t)(4 * lane + 256 * j + i) * ldwp + c];
    }
    for (int m = gw; m < nrows; m += ngw) {
        f32x4 v[4]; float s = 0.f;
#pragma unroll
        for (int j = 0; j < 4; ++j) { v[j] = ldx4<XB>(x, (size_t)m * ldx + 4 * lane + 256 * j); s += (v[j].x * v[j].x + v[j].y * v[j].y) + (v[j].z * v[j].z + v[j].w * v[j].w); }
        const float r = 1.0f / sqrtf(wave_sum_dpp(s) * (1.0f / D) + EPS);
#pragma unroll
        for (int j = 0; j < 4; ++j) v[j] = v[j] * r * g[j];
        unsigned long long* o8 = (unsigned long long*)(xn + (size_t)m * D) + lane;
#pragma unroll
        for (int j = 0; j < 4; ++j) o8[64 * j] = (unsigned long long)pk2(v[j].x, v[j].y) | ((unsigned long long)pk2(v[j].z, v[j].w) << 32);
        if (NP > 0) {
#pragma unroll
            for (int c = 0; c < NP; ++c) { float a = 0.f;
#pragma unroll
                for (int j = 0; j < 4; ++j) a += (v[j].x * wp[c][4 * j] + v[j].y * wp[c][4 * j + 1]) + (v[j].z * wp[c][4 * j + 2] + v[j].w * wp[c][4 * j + 3]);
                a = wave_sum_dpp(a);
                if (lane == 0) proj[(size_t)m * NP + c] = a; }
        }
    }
}
__device__ __forceinline__ void norm_router(const bf16_t* x, int ldx, const float* gain, bf16_t* xn, const float* Wr  , int* tok_e, float* tok_g, int* cnt  , LAS int* lcnt, int vb, int G, int wave, int lane) {
    f32x4 g[4];
#pragma unroll
    for (int j = 0; j < 4; ++j) g[j] = *(const f32x4*)(gain + 4 * lane + 256 * j);
    float wp[NEXP][16];
#pragma unroll
    for (int j = 0; j < 4; ++j)
#pragma unroll
        for (int i = 0; i < 4; ++i) { const f32x4 a = *(const f32x4*)(Wr + (size_t)(4 * lane + 256 * j + i) * NEXP), b = *(const f32x4*)(Wr + (size_t)(4 * lane + 256 * j + i) * NEXP + 4);
            wp[0][4 * j + i] = a.x; wp[1][4 * j + i] = a.y; wp[2][4 * j + i] = a.z; wp[3][4 * j + i] = a.w; wp[4][4 * j + i] = b.x; wp[5][4 * j + i] = b.y; wp[6][4 * j + i] = b.z; wp[7][4 * j + i] = b.w; }
    for (int c = vb; c < T / 128; c += G) {
        __syncthreads();
        if (threadIdx.x < NEXP) lcnt[threadIdx.x] = 0;
        __syncthreads();
        for (int rr = 0; rr < 16; ++rr) {
            const int m = c * 128 + wave * 16 + rr;
            f32x4 v[4]; float s = 0.f;
#pragma unroll
            for (int j = 0; j < 4; ++j) { v[j] = ldx4<true>(x, (size_t)m * ldx + 4 * lane + 256 * j); s += (v[j].x * v[j].x + v[j].y * v[j].y) + (v[j].z * v[j].z + v[j].w * v[j].w); }
            const float r = 1.0f / sqrtf(wave_sum_dpp(s) * (1.0f / D) + EPS);
#pragma unroll
            for (int j = 0; j < 4; ++j) v[j] = v[j] * r * g[j];
            unsigned long long* o8 = (unsigned long long*)(xn + (size_t)m * D) + lane;
#pragma unroll
            for (int j = 0; j < 4; ++j) o8[64 * j] = (unsigned long long)pk2(v[j].x, v[j].y) | ((unsigned long long)pk2(v[j].z, v[j].w) << 32);
            float a8[NEXP];
#pragma unroll
            for (int e = 0; e < NEXP; ++e) { float a = 0.f;
#pragma unroll
                for (int j = 0; j < 4; ++j) a += (v[j].x * wp[e][4 * j] + v[j].y * wp[e][4 * j + 1]) + (v[j].z * wp[e][4 * j + 2] + v[j].w * wp[e][4 * j + 3]);
                a8[e] = a; }
            float b4[4], b2[2], b1;
            { const bool up = (lane & 32) != 0;
#pragma unroll
              for (int i = 0; i < 4; ++i) { const float keep = up ? a8[4 + i] : a8[i], send = up ? a8[i] : a8[4 + i]; b4[i] = keep + shx(send, 32, lane); } }
            { const bool up = (lane & 16) != 0;
#pragma unroll
              for (int i = 0; i < 2; ++i) { const float keep = up ? b4[2 + i] : b4[i], send = up ? b4[i] : b4[2 + i]; b2[i] = keep + shx(send, 16, lane); } }
            { const bool up = (lane & 8) != 0; const float keep = up ? b2[1] : b2[0], send = up ? b2[0] : b2[1]; b1 = keep + shx(send, 8, lane); }
            b1 += shx(b1, 4, lane); b1 += shx(b1, 2, lane); b1 += shx(b1, 1, lane);
            float lg[NEXP];
#pragma unroll
            for (int e = 0; e < NEXP; ++e) lg[e] = __builtin_bit_cast(float, __builtin_amdgcn_readlane(__builtin_bit_cast(int, b1), ((e >> 2) << 5) | (((e >> 1) & 1) << 4) | ((e & 1) << 3)));
            int i1 = 0; float v1 = lg[0];
#pragma unroll
            for (int e = 1; e < NEXP; ++e) if (lg[e] > v1) { v1 = lg[e]; i1 = e; }
            int i2 = -1; float v2 = -INFINITY;
#pragma unroll
            for (int e = 0; e < NEXP; ++e) if (e != i1 && lg[e] > v2) { v2 = lg[e]; i2 = e; }
            const float e2 = __expf(v2 - v1), g1 = 1.0f / (1.0f + e2), g2 = e2 / (1.0f + e2);
            if (lane == 0) { tok_e[2 * m] = i1; tok_e[2 * m + 1] = i2; tok_g[2 * m] = g1; tok_g[2 * m + 1] = g2; atomicAdd((int*)&lcnt[i1], 1); atomicAdd((int*)&lcnt[i2], 1); }
        }
        __syncthreads();
        if (threadIdx.x < NEXP) cnt[c * NEXP + threadIdx.x] = lcnt[threadIdx.x];
    }
}
__device__ __forceinline__ void moe_assign(const int* cnt, const int* tok_e, const float* tok_g, int* tok_s, int* stok, float* sgate, int* pbase_out, const bf16_t* xn, bf16_t* ag, LAS int* lw, int vb, int G, int wave, int lane) {
    const int tid = wave * 64 + lane;
    for (int c = vb; c < T / 128; c += G) {
        __syncthreads();
        for (int i = tid; i < (T / 128) * NEXP; i += NTHR) lw[i] = cnt[i];
        if (tid < 256) lw[2100 + tid] = tok_e[c * 256 + tid];
        __syncthreads();
        if (tid < NEXP) { const int e = tid; int tot = 0, pre = 0;
            for (int cc = 0; cc < T / 128; ++cc) { const int v = lw[cc * NEXP + e]; tot += v; pre += (cc < c) ? v : 0; }
            lw[2048 + e] = tot; lw[2056 + e] = pre; }
        __syncthreads();
        if (tid == 0) { int pb = 0;
            for (int e = 0; e < NEXP; ++e) { lw[2064 + e] = pb; pb += (lw[2048 + e] + 255) >> 8; }
            lw[2064 + NEXP] = pb;
            if (c == 0) { for (int e = 0; e <= NEXP; ++e) pbase_out[e] = lw[2064 + e]; } }
        __syncthreads();
        if (tid < 256) { const int p = tid, e = lw[2100 + p]; int rank = 0;
            for (int q = 0; q < p; ++q) rank += (lw[2100 + q] == e) ? 1 : 0;
            const int pi = c * 256 + p, s = lw[2064 + e] * 256 + lw[2056 + e] + rank;
            tok_s[pi] = s; stok[s] = pi >> 1; sgate[s] = tok_g[pi]; lw[2400 + p] = s; }
        __syncthreads();
        for (int p = wave * 32; p < wave * 32 + 32; ++p) { const int pi = c * 256 + p; const int s = lw[2400 + p]; const int tk = pi >> 1;
            const u32x4* src = (const u32x4*)(xn + (size_t)tk * D) + lane; u32x4* dst = (u32x4*)(ag + (size_t)s * D) + lane;
            const u32x4 a = src[0], b = src[64]; dst[0] = a; dst[64] = b; }
    }
}
__device__ __forceinline__ void moe_combine(float* out, const bf16_t* xs, int ldx, const bf16_t* Y, const int* tok_s, const float* sgate, const float* part, const int* tmap, int tail, int S, int gw, int ngw, int lane) {
    for (int m = gw; m < T; m += ngw) {
        const int s0 = tok_s[2 * m], s1 = tok_s[2 * m + 1];
        f32x4* xr = (f32x4*)(out + (size_t)m * D) + lane;
        f32x4 v[4]; u32x2 ya[2][4]; u32x4 t4[2];
#pragma unroll
        for (int j = 0; j < 4; ++j) v[j] = ldx4<true>(xs, (size_t)m * ldx + 4 * lane + 256 * j);
#pragma unroll
        for (int k = 0; k < 2; ++k) { const int sl = k == 0 ? s0 : s1; const u32x2* y = (const u32x2*)(Y + (size_t)sl * D) + lane;
#pragma unroll
            for (int j = 0; j < 4; ++j) ya[k][j] = y[64 * j];
            t4[k] = *(const u32x4*)(tmap + (sl >> 8) * 4); }
#pragma unroll
        for (int k = 0; k < 2; ++k) { const int sl = k == 0 ? s0 : s1;
            const int any = __builtin_amdgcn_readfirstlane((int)(t4[k].x | t4[k].y | t4[k].z | t4[k].w));
            if (any == 0) {
#pragma unroll
                for (int j = 0; j < 4; ++j) { const u32x2 a = ya[k][j]; v[j].x += bflo(a.x); v[j].y += bfhi(a.x); v[j].z += bflo(a.y); v[j].w += bfhi(a.y); }
            } else {
                const int tm[4] = {__builtin_amdgcn_readfirstlane((int)t4[k].x), __builtin_amdgcn_readfirstlane((int)t4[k].y), __builtin_amdgcn_readfirstlane((int)t4[k].z), __builtin_amdgcn_readfirstlane((int)t4[k].w)};
                const float gt = sgate[sl];
#pragma unroll
                for (int j = 0; j < 4; ++j) {
                    if (tm[j] == 0) { const u32x2 a = ya[k][j]; v[j].x += bflo(a.x); v[j].y += bfhi(a.x); v[j].z += bflo(a.y); v[j].w += bfhi(a.y); }
                    else { const float* p = part + (size_t)(tm[j] - 1) * (256 * 256) + (size_t)(sl & 255) * 256 + 4 * lane;
                        f32x4 pa[14];
#pragma unroll
                        for (int s = 0; s < 14; ++s) pa[s] = *(const f32x4*)(p + (size_t)(s < S ? s : 0) * tail * (256 * 256));
                        f32x4 a = pa[0];
#pragma unroll
                        for (int s = 1; s < 14; ++s) a += pa[s] * (s < S ? 1.0f : 0.0f);
                        v[j] += a * gt; } } } }
        asm volatile("s_waitcnt vmcnt(0)" ::: "memory");
#pragma unroll
        for (int j = 0; j < 4; ++j) xr[64 * j] = v[j];
    }
}

__device__ __forceinline__ void ld8(const bf16_t* p, float* f) { const u32x4 w = *(const u32x4*)p; f[0] = bflo(w.x); f[1] = bfhi(w.x); f[2] = bflo(w.y); f[3] = bfhi(w.y); f[4] = bflo(w.z); f[5] = bfhi(w.z); f[6] = bflo(w.w); f[7] = bfhi(w.w); }
__device__ __forceinline__ void st8(bf16_t* p, const float* f) { u32x4 w; w.x = pk2(f[0], f[1]); w.y = pk2(f[2], f[3]); w.z = pk2(f[4], f[5]); w.w = pk2(f[6], f[7]); *(u32x4*)p = w; }

__device__ __forceinline__ void sb_naive(const bf16_t* QA, const bf16_t* KA, const bf16_t* VA, bf16_t* O, int gtid, int gthreads) {
    for (int item = gtid; item < T * 4; item += gthreads) {
        const int t = item % SEQ, h = (item / SEQ) & 3, b = item / (SEQ * 4);
        const size_t row = (size_t)b * SEQ + t;
        float q[64], o[64];
#pragma unroll
        for (int i = 0; i < 8; ++i) ld8(QA + row * 256 + h * 64 + 8 * i, q + 8 * i);
#pragma unroll
        for (int i = 0; i < 64; ++i) o[i] = 0.f;
        float run = 0.f;
        for (int s = t - 1; s >= 0; --s) {
            const size_t kr = ((size_t)b * SEQ + s) * 256 + h * 64;
            float dot = 0.f;
#pragma unroll
            for (int i = 0; i < 8; ++i) { float k[8]; ld8(KA + kr + 8 * i, k);
#pragma unroll
                for (int j = 0; j < 8; ++j) dot += q[8 * i + j] * k[j]; }
            const float z = dot * 0.125f;
            const float l1p = log1pf(expf(-fabsf(z)));
            const float log_beta = fminf(z, 0.f) - l1p, log_keep = fminf(-z, 0.f) - l1p;
            const float att = expf(log_beta + run);
#pragma unroll
            for (int i = 0; i < 8; ++i) { float v[8]; ld8(VA + kr + 8 * i, v);
#pragma unroll
                for (int j = 0; j < 8; ++j) o[8 * i + j] += att * v[j]; }
            run += log_keep;
            if (run < -104.f) break;
        }
#pragma unroll
        for (int i = 0; i < 8; ++i) st8(O + row * D + h * 64 + 8 * i, o + 8 * i);
    }
}
__device__ __forceinline__ void swa_naive(const bf16_t* QC, const bf16_t* KC, const bf16_t* VC, const float* sinks, const LAS float* brel  , bf16_t* O, int gtid, int gthreads) {
    for (int item = gtid; item < T * 8; item += gthreads) {
        const int h = item & 7; const int rowi = item >> 3; const int t = rowi % SEQ, b = rowi / SEQ, kv = h >> 2;
        float q[64], o[64];
#pragma unroll
        for (int i = 0; i < 8; ++i) ld8(QC + (size_t)rowi * 512 + h * 64 + 8 * i, q + 8 * i);
#pragma unroll
        for (int i = 0; i < 64; ++i) o[i] = 0.f;
        float mx = sinks[h], l = 1.0f;
        const int s0 = t - 127 < 0 ? 0 : t - 127;
        for (int s = s0; s <= t; ++s) {
            const size_t kr = ((size_t)b * SEQ + s) * 128 + kv * 64;
            float dot = 0.f;
#pragma unroll
            for (int i = 0; i < 8; ++i) { float k[8]; ld8(KC + kr + 8 * i, k);
#pragma unroll
                for (int j = 0; j < 8; ++j) dot += q[8 * i + j] * k[j]; }
            const float sc = dot * 0.125f + brel[(t - s) * 12 + 4 + h];
            if (sc > mx) { const float f = expf(mx - sc); l *= f;
#pragma unroll
                for (int i = 0; i < 64; ++i) o[i] *= f;
                mx = sc; }
            const float p = expf(sc - mx); l += p;
#pragma unroll
            for (int i = 0; i < 8; ++i) { float v[8]; ld8(VC + kr + 8 * i, v);
#pragma unroll
                for (int j = 0; j < 8; ++j) o[8 * i + j] += p * v[j]; }
        }
        const float il = 1.0f / l;
#pragma unroll
        for (int i = 0; i < 64; ++i) o[i] *= il;
#pragma unroll
        for (int i = 0; i < 8; ++i) st8(O + (size_t)rowi * D + 512 + h * 64 + 8 * i, o + 8 * i);
    }
}
__device__ __forceinline__ void dsa_naive(const bf16_t* QB, const bf16_t* KB, const bf16_t* VB, const bf16_t* QI, const bf16_t* KI, const float* WI, const LAS float* brel, bf16_t* O, LAS unsigned char* wl, int gw, int ngw, int lane) {
    LAS float* sqi = (LAS float*)wl; LAS float* sqb = sqi + 256; LAS int* sidx = (LAS int*)(sqi + 512); LAS float* sp = sqi + 768;
    const unsigned long long ltmask = (1ull << lane) - 1ull;
    for (int qrow = gw; qrow < T; qrow += ngw) {
        const int b = qrow / SEQ, t = qrow % SEQ;
        { const u32x2 a = *(const u32x2*)(QI + (size_t)qrow * 256 + 4 * lane), c = *(const u32x2*)(QB + (size_t)qrow * 256 + 4 * lane);
          sqi[4 * lane] = bflo(a.x); sqi[4 * lane + 1] = bfhi(a.x); sqi[4 * lane + 2] = bflo(a.y); sqi[4 * lane + 3] = bfhi(a.y);
          sqb[4 * lane] = bflo(c.x); sqb[4 * lane + 1] = bfhi(c.x); sqb[4 * lane + 2] = bflo(c.y); sqb[4 * lane + 3] = bfhi(c.y); }
        const f32x4 wi = *(const f32x4*)(WI + (size_t)qrow * 4);
        LDS_WAIT(); asm volatile("" ::: "memory");
        unsigned key[32];
#pragma unroll
        for (int r = 0; r < 32; ++r) {
            key[r] = 0u;
            if (64 * r <= t) {
                const int s = 64 * r + lane;
                if (s <= t) {
                    float dd[4] = {0.f, 0.f, 0.f, 0.f};
#pragma unroll
                    for (int i = 0; i < 8; ++i) { float k[8]; ld8(KI + ((size_t)b * SEQ + s) * 64 + 8 * i, k);
#pragma unroll
                        for (int h = 0; h < 4; ++h)
#pragma unroll
                            for (int j = 0; j < 8; ++j) dd[h] += sqi[h * 64 + 8 * i + j] * k[j]; }
                    float sc = 0.f;
#pragma unroll
                    for (int h = 0; h < 4; ++h) { const float d = dd[h] * 0.125f; sc += wi[h] * (d > 0.f ? d : 0.f); }
                    const unsigned u = __builtin_bit_cast(unsigned, sc);
                    key[r] = (u & 0x80000000u) ? ~u : (u | 0x80000000u);
                }
            }
        }
        const int nvalid = t + 1;
        unsigned tau = 0u; int need = 0;
        if (nvalid > 256) {
            unsigned lo = 0u, hi = 0xFFFFFFFFu;
            while (hi - lo > 1u) { const unsigned mid = lo + ((hi - lo) >> 1); int c = 0;
#pragma unroll
                for (int r = 0; r < 32; ++r) c += __popcll(__ballot(key[r] > mid));
                if (c >= 256) lo = mid; else hi = mid; }
            tau = hi; int ngt = 0;
#pragma unroll
            for (int r = 0; r < 32; ++r) ngt += __popcll(__ballot(key[r] > tau));
            need = 256 - ngt;
        }
        int pos = 0, tie_seen = 0;
#pragma unroll
        for (int r = 0; r < 32; ++r) {
            const bool gt = key[r] > tau; const bool eq = (nvalid > 256) && (key[r] == tau);
            const unsigned long long meq = __ballot(eq);
            const bool sel = gt || (eq && (tie_seen + __popcll(meq & ltmask)) < need);
            tie_seen += __popcll(meq);
            const unsigned long long ms = __ballot(sel);
            if (sel) sidx[pos + __popcll(ms & ltmask)] = 64 * r + lane;
            pos += __popcll(ms);
        }
        const int nsel = pos;
        LDS_WAIT(); asm volatile("" ::: "memory");
        float sc4[4][4];
#pragma unroll
        for (int i = 0; i < 4; ++i) { const int j = lane + 64 * i;
            if (j < nsel) { const int s = sidx[j]; float dd[4] = {0.f, 0.f, 0.f, 0.f};
#pragma unroll
                for (int ii = 0; ii < 8; ++ii) { float k[8]; ld8(KB + ((size_t)b * SEQ + s) * 64 + 8 * ii, k);
#pragma unroll
                    for (int h = 0; h < 4; ++h)
#pragma unroll
                        for (int jj = 0; jj < 8; ++jj) dd[h] += sqb[h * 64 + 8 * ii + jj] * k[jj]; }
                int rel = t - s; rel = rel > 127 ? 127 : rel;
#pragma unroll
                for (int h = 0; h < 4; ++h) sc4[i][h] = dd[h] * 0.125f + brel[rel * 12 + h];
            } else {
#pragma unroll
                for (int h = 0; h < 4; ++h) sc4[i][h] = -INFINITY; } }
#pragma unroll
        for (int h = 0; h < 4; ++h) {
            const float mx = wave_max(fmaxf(fmaxf(sc4[0][h], sc4[1][h]), fmaxf(sc4[2][h], sc4[3][h])), lane);
            float e[4], su = 0.f;
#pragma unroll
            for (int i = 0; i < 4; ++i) { e[i] = expf(sc4[i][h] - mx); su += e[i]; }
            su = wave_sum(su, lane); const float inv = 1.0f / su;
#pragma unroll
            for (int i = 0; i < 4; ++i) sp[h * 256 + lane + 64 * i] = e[i] * inv;
        }
        LDS_WAIT(); asm volatile("" ::: "memory");
        float o[4] = {0.f, 0.f, 0.f, 0.f};
        for (int j = 0; j < nsel; ++j) { const int s = sidx[j]; const float v = bf2f(VB[((size_t)b * SEQ + s) * 64 + lane]);
#pragma unroll
            for (int h = 0; h < 4; ++h) o[h] += sp[h * 256 + j] * v; }
#pragma unroll
        for (int h = 0; h < 4; ++h) O[(size_t)qrow * D + 256 + h * 64 + lane] = (bf16_t)f2bf(o[h]);
        LDS_WAIT(); asm volatile("" ::: "memory");
    }
}
__device__ __forceinline__ float sum16(float v, int lane) { v += shx(v, 1, lane); v += shx(v, 2, lane); v += shx(v, 4, lane); v += shx(v, 8, lane); return v; }
__device__ __forceinline__ void xattn_naive(const bf16_t* QX, const bf16_t* MKV  , const float* qn, bf16_t* OX, int gw, int ngw, int lane) {
    const int h = lane >> 4, part = lane & 15;
    float gq[8];
#pragma unroll
    for (int i = 0; i < 8; ++i) gq[i] = qn[part * 8 + i];
    for (int row = gw; row < T; row += ngw) {
        const int b = row / SEQ;
        float q[8]; ld8(QX + (size_t)row * 512 + h * 128 + part * 8, q);
        float ss = 0.f;
#pragma unroll
        for (int i = 0; i < 8; ++i) ss += q[i] * q[i];
        ss = sum16(ss, lane);
        const float r = 1.0f / sqrtf(ss * (1.0f / 128.0f) + EPS) * 0.08838834764831845f;
#pragma unroll
        for (int i = 0; i < 8; ++i) q[i] = q[i] * r * gq[i];
        float mx = -INFINITY, l = 0.f, o[8];
#pragma unroll
        for (int i = 0; i < 8; ++i) o[i] = 0.f;
        for (int j = 0; j < NMEM; ++j) {
            const bf16_t* kp = MKV + ((size_t)b * NMEM + j) * D + h * 128 + part * 8;
            float k[8], v[8]; ld8(kp, k); ld8(kp + 512, v);
            float d = 0.f;
#pragma unroll
            for (int i = 0; i < 8; ++i) d += q[i] * k[i];
            d = sum16(d, lane);
            if (d > mx) { const float f = expf(mx - d); l *= f;
#pragma unroll
                for (int i = 0; i < 8; ++i) o[i] *= f;
                mx = d; }
            const float p = expf(d - mx); l += p;
#pragma unroll
            for (int i = 0; i < 8; ++i) o[i] += p * v[i];
        }
        const float il = 1.0f / l;
#pragma unroll
        for (int i = 0; i < 8; ++i) o[i] *= il;
        st8(OX + (size_t)row * 512 + h * 128 + part * 8, o);
    }
}
__device__ __forceinline__ void memk_norm(bf16_t* MKV  , const float* kn_x  , int gw, int ngw, int lane) {
    const int h = lane >> 4, part = lane & 15;
    for (int row = gw; row < 2 * TM; row += ngw) {
        const int l = row / TM;
        bf16_t* kp = MKV + (size_t)row * D + h * 128 + part * 8;
        float k[8]; ld8(kp, k);
        float ss = 0.f;
#pragma unroll
        for (int i = 0; i < 8; ++i) ss += k[i] * k[i];
        ss = sum16(ss, lane);
        const float r = 1.0f / sqrtf(ss * (1.0f / 128.0f) + EPS);
#pragma unroll
        for (int i = 0; i < 8; ++i) k[i] = k[i] * r * kn_x[l * 128 + part * 8 + i];
        st8(kp, k);
    }
}
typedef float f32x16 __attribute__((ext_vector_type(16)));
typedef short s16x4 __attribute__((ext_vector_type(4)));
#define LOG2E 1.4426950408889634f
#ifndef KDIRECT
#define KDIRECT 0
#endif
__device__ __forceinline__ f32x16 zero16() { float z = 0.f; asm volatile("" : "+v"(z)); return (f32x16){z, z, z, z, z, z, z, z, z, z, z, z, z, z, z, z}; }
__device__ __forceinline__ int crow(int r, int hi) { return (r & 3) + 8 * (r >> 2) + 4 * hi; }
__device__ __forceinline__ void xhalf_pair(float v, float& own_lo, float& own_hi) { float a = v, b = v;
    asm volatile("s_nop 1\n\tv_permlane32_swap_b32 %0, %1\n\ts_nop 1" : "+v"(a), "+v"(b)); own_lo = a; own_hi = b; }
__device__ __forceinline__ float xhalf_max(float v) { float x, y; xhalf_pair(v, x, y); return fmaxf(x, y); }
__device__ __forceinline__ float xhalf_sum(float v) { float x, y; xhalf_pair(v, x, y); return x + y; }

__device__ __forceinline__ s16x4 vtr(const LAS unsigned char* p) { return __builtin_bit_cast(s16x4, __builtin_amdgcn_ds_read_tr16_b64_v4i16((LAS s16x4*)p)); }
__device__ __forceinline__ bf16x8 mk8(s16x4 lo, s16x4 hi) { return (bf16x8){lo[0], lo[1], lo[2], lo[3], hi[0], hi[1], hi[2], hi[3]}; }
__device__ __forceinline__ bf16x8 pack8(const float* p) { u32x4 w; w.x = cvt_pk_bf16(p[0], p[1]); w.y = cvt_pk_bf16(p[2], p[3]); w.z = cvt_pk_bf16(p[4], p[5]); w.w = cvt_pk_bf16(p[6], p[7]); return __builtin_bit_cast(bf16x8, w); }
__device__ __forceinline__ int vtr_base(int lane, int vstr) { const int hi = lane >> 5, g1 = (lane >> 4) & 1, i = lane & 15; return (4 * hi + (i >> 2)) * vstr + (16 * g1 + 4 * (i & 3)) * 2; }

__device__ __forceinline__ void xattn_mfma(const bf16_t* QX, const bf16_t* MKV, const float* qn, bf16_t* OX, LAS unsigned char* lds, int vcu, int G, int tid) {
    const int lane = tid & 63, wave = __builtin_amdgcn_readfirstlane(tid >> 6), c = lane & 31, hi = lane >> 5;
    constexpr int KSTR = 272, VSTR = 320, VOFF = 256 * KSTR;
    const int vb = VOFF + vtr_base(lane, VSTR);
    for (int unit = vcu; unit < BATCH * 4 * 8; unit += G) {
        const int b = unit >> 5, h = (unit >> 3) & 3, qb = unit & 7;
        const size_t qrow = (size_t)b * SEQ + qb * 256 + wave * 32 + c;
        __syncthreads();
#pragma unroll 4
        for (int i = 0; i < 8; ++i) { const int id = tid + 512 * i, row = id >> 4, ch = id & 15;
            const bf16_t* src = MKV + ((size_t)(b * NMEM + row)) * D + h * 128 + ch * 8;
            *(LAS u32x4*)(lds + row * KSTR + ch * 16) = *(const u32x4*)src; }
        asm volatile("" ::: "memory");
#pragma unroll 4
        for (int i = 0; i < 8; ++i) { const int id = tid + 512 * i, row = id >> 4, ch = id & 15;
            const bf16_t* src = MKV + ((size_t)(b * NMEM + row)) * D + 512 + h * 128 + ch * 8;
            *(LAS u32x4*)(lds + VOFF + row * VSTR + ch * 16) = *(const u32x4*)src; }
        asm volatile("" ::: "memory");
        bf16x8 qf[8];
        { float q[8][8]; float ss = 0.f;
#pragma unroll
          for (int ks = 0; ks < 8; ++ks) { ld8(QX + qrow * 512 + h * 128 + 16 * ks + 8 * hi, q[ks]);
#pragma unroll
              for (int j = 0; j < 8; ++j) ss += q[ks][j] * q[ks][j]; }
          ss = xhalf_sum(ss);
          const float r = 1.0f / sqrtf(ss * (1.0f / 128.0f) + EPS) * (0.08838834764831845f * LOG2E);
#pragma unroll
          for (int ks = 0; ks < 8; ++ks) { float t[8];
#pragma unroll
              for (int j = 0; j < 8; ++j) t[j] = q[ks][j] * r * qn[16 * ks + 8 * hi + j];
              qf[ks] = pack8(t); } }
        __syncthreads();
        f32x16 O[4];
#pragma unroll
        for (int dt = 0; dt < 4; ++dt) O[dt] = zero16();
        float m = -1e30f, l = 0.f;
        for (int kt = 0; kt < 8; ++kt) {
            f32x16 S = zero16();
#pragma unroll
            for (int ks = 0; ks < 8; ++ks) {
#if KDIRECT
                const bf16x8 kf = *(const bf16x8*)(MKV + ((size_t)(b * NMEM + kt * 32 + c)) * D + h * 128 + 16 * ks + 8 * hi);
#else
                const bf16x8 kf = *(const LAS bf16x8*)(lds + (kt * 32 + c) * KSTR + (16 * ks + 8 * hi) * 2);
#endif
                S = __builtin_amdgcn_mfma_f32_32x32x16_bf16(kf, qf[ks], S, 0, 0, 0); }
            float tm = S[0];
#pragma unroll
            for (int r = 1; r < 16; ++r) tm = fmaxf(tm, S[r]);
            const float mn = fmaxf(m, xhalf_max(tm));
            const float f = __builtin_amdgcn_exp2f(m - mn); m = mn;
            float p[16], ps = 0.f;
#pragma unroll
            for (int r = 0; r < 16; ++r) { p[r] = __builtin_amdgcn_exp2f(S[r] - mn); ps += p[r]; }
            l = l * f + ps;
#pragma unroll
            for (int dt = 0; dt < 4; ++dt) O[dt] *= f;
            const bf16x8 pf0 = pack8(p), pf1 = pack8(p + 8);
#pragma unroll
            for (int dt = 0; dt < 4; ++dt) { const LAS unsigned char* vp = lds + vb + (kt * 32) * VSTR + dt * 64;
                const bf16x8 v0 = mk8(vtr(vp), vtr(vp + 8 * VSTR)), v1 = mk8(vtr(vp + 16 * VSTR), vtr(vp + 24 * VSTR));
                O[dt] = __builtin_amdgcn_mfma_f32_32x32x16_bf16(v0, pf0, O[dt], 0, 0, 0);
                O[dt] = __builtin_amdgcn_mfma_f32_32x32x16_bf16(v1, pf1, O[dt], 0, 0, 0); }
        }
        const float il = 1.0f / xhalf_sum(l);
#pragma unroll
        for (int dt = 0; dt < 4; ++dt)
#pragma unroll
            for (int g = 0; g < 4; ++g) { u32x2 w; w.x = cvt_pk_bf16(O[dt][4 * g] * il, O[dt][4 * g + 1] * il); w.y = cvt_pk_bf16(O[dt][4 * g + 2] * il, O[dt][4 * g + 3] * il);
                *(u32x2*)(OX + qrow * 512 + h * 128 + dt * 32 + 8 * g + 4 * hi) = w; }
    }
}

__device__ __forceinline__ void swa_mfma(const bf16_t* QC, const bf16_t* KC, const bf16_t* VC, const float* sinks, const LAS float* brel, bf16_t* O, LAS unsigned char* lds, int vcu, int G, int tid) {
    const int lane = tid & 63, wave = __builtin_amdgcn_readfirstlane(tid >> 6), c = lane & 31, hi = lane >> 5;
    constexpr int KSTR = 144, VSTR = 192, VOFF = 192 * KSTR;
    const int vb = VOFF + vtr_base(lane, VSTR);
    const int g = wave >> 1, qh = wave & 1;
    for (int unit = vcu; unit < BATCH * 2 * 32; unit += G) {
        const int b = unit >> 6, kvh = (unit >> 5) & 1, qb = unit & 31, q0 = qb * 64, head = kvh * 4 + g;
        __syncthreads();
#pragma unroll
        for (int i = 0; i < 3; ++i) { const int id = tid + 512 * i, row = id >> 3, ch = id & 7; int kr = q0 - 128 + row; kr = kr < 0 ? 0 : kr;
            const size_t src = ((size_t)b * SEQ + kr) * 128 + kvh * 64 + ch * 8;
            *(LAS u32x4*)(lds + row * KSTR + ch * 16) = *(const u32x4*)(KC + src);
            *(LAS u32x4*)(lds + VOFF + row * VSTR + ch * 16) = *(const u32x4*)(VC + src); }
        const int t = q0 + 32 * qh + c; const size_t qrow = (size_t)b * SEQ + t;
        bf16x8 qf[4];
#pragma unroll
        for (int ks = 0; ks < 4; ++ks) qf[ks] = *(const bf16x8*)(QC + qrow * 512 + head * 64 + 16 * ks + 8 * hi);
        const float sink = sinks[head] * LOG2E;
        __syncthreads();
        f32x16 Oa[2];
#pragma unroll
        for (int dt = 0; dt < 2; ++dt) Oa[dt] = zero16();
        float m = sink, l = 0.5f;
        const int rb = c + 128 - 4 * hi;
        const int sp0 = q0 - 128 + 32 * qh + 4 * hi;
        const LAS float* bh = brel + 4 + head;
        for (int kt = 0; kt < 5; ++kt) {
            f32x16 S = zero16();
#pragma unroll
            for (int ks = 0; ks < 4; ++ks) {
#if KDIRECT
                int kr = q0 - 128 + (kt + qh) * 32 + c; kr = kr < 0 ? 0 : kr;
                const bf16x8 kf = *(const bf16x8*)(KC + ((size_t)b * SEQ + kr) * 128 + kvh * 64 + 16 * ks + 8 * hi);
#else
                const bf16x8 kf = *(const LAS bf16x8*)(lds + ((kt + qh) * 32 + c) * KSTR + (16 * ks + 8 * hi) * 2);
#endif
                S = __builtin_amdgcn_mfma_f32_32x32x16_bf16(kf, qf[ks], S, 0, 0, 0); }
            float sv[16], tm = -1e30f;
#pragma unroll
            for (int r = 0; r < 16; ++r) { const int cr = 32 * kt + (r & 3) + 8 * (r >> 2);
                const int rel = rb - cr, spos = sp0 + cr;
                const int inv = (rel | (127 - rel) | spos) >> 31;
                const int relc = rel < 0 ? 0 : (rel > 127 ? 127 : rel);
                const float v = S[r] * (0.125f * LOG2E) + bh[relc * 12] * LOG2E;
                const float cap = __builtin_bit_cast(float, 0x7F800000u | ((unsigned)inv & 0x80000000u));
                sv[r] = fminf(v, cap); tm = fmaxf(tm, sv[r]); }
            const float mn = fmaxf(m, xhalf_max(tm));
            const float f = __builtin_amdgcn_exp2f(m - mn); m = mn;
            float p[16], ps = 0.f;
#pragma unroll
            for (int r = 0; r < 16; ++r) { p[r] = __builtin_amdgcn_exp2f(sv[r] - mn); ps += p[r]; }
            l = l * f + ps;
#pragma unroll
            for (int dt = 0; dt < 2; ++dt) Oa[dt] *= f;
            const bf16x8 pf0 = pack8(p), pf1 = pack8(p + 8);
#pragma unroll
            for (int dt = 0; dt < 2; ++dt) { const LAS unsigned char* vp = lds + vb + ((kt + qh) * 32) * VSTR + dt * 64;
                const bf16x8 v0 = mk8(vtr(vp), vtr(vp + 8 * VSTR)), v1 = mk8(vtr(vp + 16 * VSTR), vtr(vp + 24 * VSTR));
                Oa[dt] = __builtin_amdgcn_mfma_f32_32x32x16_bf16(v0, pf0, Oa[dt], 0, 0, 0);
                Oa[dt] = __builtin_amdgcn_mfma_f32_32x32x16_bf16(v1, pf1, Oa[dt], 0, 0, 0); }
        }
        const float il = 1.0f / xhalf_sum(l);
#pragma unroll
        for (int dt = 0; dt < 2; ++dt)
#pragma unroll
            for (int gg = 0; gg < 4; ++gg) { u32x2 w; w.x = cvt_pk_bf16(Oa[dt][4 * gg] * il, Oa[dt][4 * gg + 1] * il); w.y = cvt_pk_bf16(Oa[dt][4 * gg + 2] * il, Oa[dt][4 * gg + 3] * il);
                *(u32x2*)(O + qrow * D + 512 + head * 64 + dt * 32 + 8 * gg + 4 * hi) = w; }
    }
}

__device__ __forceinline__ float log_sig(float z, float l1p) { return fminf(z, 0.f) - l1p; }
__device__ __forceinline__ void sb_mfma(const bf16_t* QA, const bf16_t* KA, const bf16_t* VA, bf16_t* O, LAS unsigned char* wl, int gw, int ngw, int lane) {
    const int c = lane & 31, hi = lane >> 5;
    constexpr int VSTR = 192;
    const int vb = vtr_base(lane, VSTR);
    for (int item = gw; item < BATCH * 4 * 64; item += ngw) {
        const int b = item >> 8, h = (item >> 6) & 3, qb = item & 63, q0 = qb * 32;
        const size_t qrow = (size_t)b * SEQ + q0 + c;
        bf16x8 qf[4];
#pragma unroll
        for (int ks = 0; ks < 4; ++ks) qf[ks] = *(const bf16x8*)(QA + qrow * 256 + h * 64 + 16 * ks + 8 * hi);
        f32x16 Oa[2];
#pragma unroll
        for (int dt = 0; dt < 2; ++dt) Oa[dt] = zero16();
        float carry = 0.f;
        bf16x8 kf[4], kn[4] = {}; u32x4 vr[4], vn[4] = {};
        { const size_t krow0 = (size_t)b * SEQ + qb * 32;
#pragma unroll
          for (int ks = 0; ks < 4; ++ks) kf[ks] = *(const bf16x8*)(KA + (krow0 + c) * 256 + h * 64 + 16 * ks + 8 * hi);
#pragma unroll
          for (int i = 0; i < 4; ++i) { const int id = lane + 64 * i, row = id >> 3, ch = id & 7; vr[i] = *(const u32x4*)(VA + (krow0 + row) * 256 + h * 64 + ch * 8); } }
        for (int kt = qb; kt >= 0; --kt) {
#pragma unroll
            for (int i = 0; i < 4; ++i) { const int id = lane + 64 * i, row = id >> 3, ch = id & 7; *(LAS u32x4*)(wl + row * VSTR + ch * 16) = vr[i]; }
            if (kt > 0) { const size_t krow1 = (size_t)b * SEQ + (kt - 1) * 32;
#pragma unroll
                for (int ks = 0; ks < 4; ++ks) kn[ks] = *(const bf16x8*)(KA + (krow1 + c) * 256 + h * 64 + 16 * ks + 8 * hi);
#pragma unroll
                for (int i = 0; i < 4; ++i) { const int id = lane + 64 * i, row = id >> 3, ch = id & 7; vn[i] = *(const u32x4*)(VA + (krow1 + row) * 256 + h * 64 + ch * 8); } }
            f32x16 S = zero16();
#pragma unroll
            for (int ks = 0; ks < 4; ++ks) S = __builtin_amdgcn_mfma_f32_32x32x16_bf16(kf[ks], qf[ks], S, 0, 0, 0);
            const bool diag = (kt == qb);
            float lk[16], lb[16];
            const int dm = diag ? (c - 1 - 4 * hi) : 64;
#pragma unroll
            for (int r = 0; r < 16; ++r) { const float z = S[r] * 0.125f; const float l1p = 0.6931471805599453f * __builtin_amdgcn_logf(1.0f + __builtin_amdgcn_exp2f(fabsf(z) * -1.4426950408889634f));
                const int inv = (dm - ((r & 3) + 8 * (r >> 2))) >> 31;
                const float cap = __builtin_bit_cast(float, 0x7F800000u | ((unsigned)inv & 0x80000000u));
                lb[r] = fminf(log_sig(z, l1p), cap);
                lk[r] = __builtin_bit_cast(float, __builtin_bit_cast(unsigned, log_sig(-z, l1p)) & ~(unsigned)inv); }
            float gs[4], go[4];
#pragma unroll
            for (int q = 0; q < 4; ++q) { gs[q] = (lk[4 * q] + lk[4 * q + 1]) + (lk[4 * q + 2] + lk[4 * q + 3]);
                float x, y; xhalf_pair(gs[q], x, y); go[q] = hi ? x : y; }
            float suf[4];
            { float a = 0.f;
#pragma unroll
              for (int q = 3; q >= 0; --q) {
                  suf[q] = a + (hi ? 0.f : go[q]);
                  a += gs[q] + go[q]; }
              float p[16];
#pragma unroll
              for (int q = 0; q < 4; ++q) { float w = suf[q] + carry;
#pragma unroll
                  for (int i = 3; i >= 0; --i) { p[4 * q + i] = __expf(lb[4 * q + i] + w); w += lk[4 * q + i]; } }
              carry += a;
              asm volatile("s_waitcnt lgkmcnt(0)" ::: "memory");
              const bf16x8 pf0 = pack8(p), pf1 = pack8(p + 8);
#pragma unroll
              for (int dt = 0; dt < 2; ++dt) { const LAS unsigned char* vp = wl + vb + dt * 64;
                  const bf16x8 v0 = mk8(vtr(vp), vtr(vp + 8 * VSTR)), v1 = mk8(vtr(vp + 16 * VSTR), vtr(vp + 24 * VSTR));
                  Oa[dt] = __builtin_amdgcn_mfma_f32_32x32x16_bf16(v0, pf0, Oa[dt], 0, 0, 0);
                  Oa[dt] = __builtin_amdgcn_mfma_f32_32x32x16_bf16(v1, pf1, Oa[dt], 0, 0, 0); }
              asm volatile("s_waitcnt lgkmcnt(0)" ::: "memory"); }
#pragma unroll
            for (int i = 0; i < 4; ++i) { kf[i] = kn[i]; vr[i] = vn[i]; }
            if (__all(carry < -104.f)) break;
        }
#pragma unroll
        for (int dt = 0; dt < 2; ++dt)
#pragma unroll
            for (int gg = 0; gg < 4; ++gg) { u32x2 w; w.x = cvt_pk_bf16(Oa[dt][4 * gg], Oa[dt][4 * gg + 1]); w.y = cvt_pk_bf16(Oa[dt][4 * gg + 2], Oa[dt][4 * gg + 3]);
                *(u32x2*)(O + qrow * D + h * 64 + dt * 32 + 8 * gg + 4 * hi) = w; }
    }
}

__device__ __forceinline__ void dsa_mfma(const bf16_t* QB, const bf16_t* KB, const bf16_t* VB, const bf16_t* QI, const bf16_t* KI, const float* WI, const LAS float* brel, bf16_t* O, LAS unsigned char* lds, int vcu, int G, int tid) {
    const int lane = tid & 63, wave = __builtin_amdgcn_readfirstlane(tid >> 6), c = lane & 31, hi = lane >> 5, c16 = lane & 15, g4 = lane >> 4;
    constexpr int SCSTR = 2052, BM_OFF = 16 * SCSTR * 4, BMSTR = 65, VSTR = 192;
    LAS float* sc = (LAS float*)lds; LAS unsigned* bm = (LAS unsigned*)(lds + BM_OFF); LAS int* rowctr = (LAS int*)(lds + 154624);
    LAS unsigned char* wl = lds + wave * 6144;
    const int vb = vtr_base(lane, VSTR);
    const unsigned long long ltmask = (1ull << lane) - 1ull;
    for (int item = vcu; item < BATCH * 16; item += G) {
      const int b = item >> 4, sidx = item & 15;
      for (int u = 0; u < 2; ++u) {
        const int qb = u == 0 ? sidx : 31 - sidx, q0 = qb * 64;
        bf16x8 qfn[4][2]; f32x4 win;
#define DSA_QLOAD(subi) do { const size_t qr_ = (size_t)b * SEQ + q0 + 16 * (subi) + c16; \
        _Pragma("unroll") for (int h = 0; h < 4; ++h) _Pragma("unroll") for (int ks = 0; ks < 2; ++ks) qfn[h][ks] = *(const bf16x8*)(QI + qr_ * 256 + h * 64 + 32 * ks + 8 * g4); \
        win = *(const f32x4*)(WI + qr_ * 4); } while (0)
        DSA_QLOAD(0);
        bf16x8 kf0[2][2];
#pragma unroll
        for (int j = 0; j < 2; ++j)
#pragma unroll
            for (int ks = 0; ks < 2; ++ks) kf0[j][ks] = *(const bf16x8*)(KI + ((size_t)b * SEQ + (wave + 8 * j) * 16 + c16) * 64 + 32 * ks + 8 * g4);
        for (int sub = 0; sub < 4; ++sub) {
            const int q0s = q0 + 16 * sub;
            __syncthreads();
            if (tid == 0) *rowctr = 0;
            {
                bf16x8 qf[4][2];
#pragma unroll
                for (int h = 0; h < 4; ++h)
#pragma unroll
                    for (int ks = 0; ks < 2; ++ks) qf[h][ks] = qfn[h][ks];
                const f32x4 wi = win * 0.125f;
                const int nt16 = (q0s >> 4) + 1, tq = q0s + c16;
                bf16x8 kf[2][2], kn[2][2] = {};
#pragma unroll
                for (int j = 0; j < 2; ++j)
#pragma unroll
                    for (int ks = 0; ks < 2; ++ks) kf[j][ks] = kf0[j][ks];
                for (int kt = wave; kt < nt16; kt += 16) {
#pragma unroll
                    for (int j = 0; j < 2; ++j) if (kt + 16 + 8 * j < nt16) {
#pragma unroll
                        for (int ks = 0; ks < 2; ++ks) kn[j][ks] = *(const bf16x8*)(KI + ((size_t)b * SEQ + (kt + 16 + 8 * j) * 16 + c16) * 64 + 32 * ks + 8 * g4); }
#pragma unroll
                    for (int j = 0; j < 2; ++j) if (kt + 8 * j < nt16) {
                        const int key0 = (kt + 8 * j) * 16;
                        f32x4 s4 = {0.f, 0.f, 0.f, 0.f};
#pragma unroll
                        for (int h = 0; h < 4; ++h) { float z = 0.f; asm volatile("" : "+v"(z)); f32x4 a = {z, z, z, z};
                            a = __builtin_amdgcn_mfma_f32_16x16x32_bf16(kf[j][0], qf[h][0], a, 0, 0, 0);
                            a = __builtin_amdgcn_mfma_f32_16x16x32_bf16(kf[j][1], qf[h][1], a, 0, 0, 0);
#pragma unroll
                            for (int r = 0; r < 4; ++r) s4[r] = __builtin_fmaf(wi[h], __builtin_fmaxf(a[r], 0.f), s4[r]); }
#pragma unroll
                        for (int r = 0; r < 4; ++r) if (key0 + 4 * g4 + r > tq) s4[r] = -INFINITY;
                        *(LAS f32x4*)(sc + c16 * SCSTR + key0 + 4 * g4) = s4; }
#pragma unroll
                    for (int j = 0; j < 2; ++j) { kf[j][0] = kn[j][0]; kf[j][1] = kn[j][1]; }
                }
                DSA_QLOAD(sub < 3 ? sub + 1 : 3);
            }
            __syncthreads();
            for (;;) {
                int ql = 0; if (lane == 0) ql = __atomic_fetch_add(rowctr, 1, __ATOMIC_RELAXED);
                ql = __builtin_amdgcn_readfirstlane(ql);
                if (ql >= 16) break;
                const int t = q0s + ql;
                float v[32];
#pragma unroll
                for (int r = 0; r < 32; ++r) { const int s = 64 * r + lane; const float x = sc[ql * SCSTR + s]; v[r] = (s <= t) ? x : -INFINITY; }
                const int nvalid = t + 1;
                float tau = -INFINITY; int need = 0;
#define DSA_CMP8(OP, b, thr, M) asm volatile(OP " %0, %9, %8\n\t" OP " %1, %10, %8\n\t" OP " %2, %11, %8\n\t" OP " %3, %12, %8\n\t" \
        OP " %4, %13, %8\n\t" OP " %5, %14, %8\n\t" OP " %6, %15, %8\n\t" OP " %7, %16, %8" \
        : "=s"(M[0]), "=s"(M[1]), "=s"(M[2]), "=s"(M[3]), "=s"(M[4]), "=s"(M[5]), "=s"(M[6]), "=s"(M[7]) \
        : "v"(thr), "v"(v[b]), "v"(v[b + 1]), "v"(v[b + 2]), "v"(v[b + 3]), "v"(v[b + 4]), "v"(v[b + 5]), "v"(v[b + 6]), "v"(v[b + 7]))
#define DSA_COUNT_OP(OP, dst, thr) do { const float _t = (thr); int _c = 0; _Pragma("unroll") for (int _g = 0; _g < 4; ++_g) { unsigned long long _m[8]; DSA_CMP8(OP, 8 * _g, _t, _m); \
        _c += (__popcll(_m[0]) + __popcll(_m[1])) + (__popcll(_m[2]) + __popcll(_m[3])) + ((__popcll(_m[4]) + __popcll(_m[5])) + (__popcll(_m[6]) + __popcll(_m[7]))); } dst = _c; } while (0)
#define DSA_COUNT_GT(dst, thr) DSA_COUNT_OP("v_cmp_gt_f32_e64", dst, thr)
#define DSA_COUNT_GE(dst, thr) DSA_COUNT_OP("v_cmp_ge_f32_e64", dst, thr)
#define DSA_F(cnt) (__builtin_amdgcn_logf((float)(cnt) + 0.5f) - 8.0f)
                if (nvalid > 256) {
                    float mx = v[0];
#pragma unroll
                    for (int r = 1; r < 32; ++r) mx = fmaxf(mx, v[r]);
                    mx = wave_max_dpp(mx);
                    float lo = 0.f, hi = mx, flo = 0.f, fhi = -9.0f; bool done = false, needmin = true;
                    if (mx > 0.f) { int cg; DSA_COUNT_GT(cg, 0.f);
                        if (cg == 256) { tau = 0.f; need = 0; done = true; needmin = false; }
                        else if (cg > 256) { lo = 0.f; flo = DSA_F(cg); needmin = false; }
                        else { int ce; DSA_COUNT_GE(ce, 0.f);
                            if (ce >= 256) { tau = 0.f; need = 256 - cg; done = true; needmin = false; }
                            else { hi = 0.f; fhi = DSA_F(cg); } } }
                    if (needmin) { float mn = INFINITY;
#pragma unroll
                        for (int r = 0; r < 32; ++r) mn = fminf(mn, (64 * r + lane <= t) ? v[r] : INFINITY);
                        mn = -wave_max(-mn, lane);
                        int cmin; DSA_COUNT_GT(cmin, mn);
                        if (cmin < 256) { tau = mn; need = 256 - cmin; done = true; }
                        else if (cmin == 256) { tau = mn; need = 0; done = true; }
                        else { lo = mn; flo = DSA_F(cmin); } }
                    {
                        int side = 0;
                        for (int it = 0; it < 24 && !done; ++it) {
                            float p = lo + (hi - lo) * (flo * __builtin_amdgcn_rcpf(flo - fhi));
                            if (!(p > lo && p < hi)) { p = lo + (hi - lo) * 0.5f;
                                if (!(p > lo && p < hi)) { tau = hi; int c; DSA_COUNT_GT(c, hi); need = 256 - c; done = true; break; } }
                            int c; DSA_COUNT_GT(c, p);
                            if (c == 256) { tau = p; need = 0; done = true; }
                            else if (c > 256) { lo = p; flo = DSA_F(c); if (side > 0) fhi *= 0.5f; side = 1; }
                            else { hi = p; fhi = DSA_F(c); if (side < 0) flo *= 0.5f; side = -1; } }
                        if (!done) {
                            auto okey = [](float f) { const unsigned u = __builtin_bit_cast(unsigned, f); return (u & 0x80000000u) ? ~u : (u | 0x80000000u); };
                            auto ofloat = [](unsigned k) { const unsigned u = (k & 0x80000000u) ? (k & 0x7FFFFFFFu) : ~k; return __builtin_bit_cast(float, u); };
                            unsigned kl = okey(lo), kh = okey(hi);
                            while (kh - kl > 1u) { const unsigned km = kl + ((kh - kl) >> 1); const float mid = ofloat(km); int c; DSA_COUNT_GT(c, mid);
                                if (c >= 256) kl = km; else kh = km; }
                            tau = ofloat(kh); int c; DSA_COUNT_GT(c, tau); need = 256 - c; if (need < 0) need = 0;
                        }
                    }
                }
#undef DSA_F
#undef DSA_COUNT_GE
#undef DSA_COUNT_OP
#undef DSA_COUNT_GT
#undef DSA_CMP8
                unsigned mylo = 0u, myhi = 0u;
                if (need == 0) {
#pragma unroll
                    for (int r = 0; r < 32; ++r) { const unsigned long long ms = __ballot(v[r] > tau); if (lane == r) { mylo = (unsigned)ms; myhi = (unsigned)(ms >> 32); } }
                } else {
                    int tie_seen = 0;
#pragma unroll
                    for (int r = 0; r < 32; ++r) {
                        const bool gt = v[r] > tau; const bool eq = (v[r] == tau);
                        const unsigned long long meq = __ballot(eq);
                        const bool sel = gt || (eq && (tie_seen + __popcll(meq & ltmask)) < need);
                        tie_seen += __popcll(meq);
                        const unsigned long long ms = __ballot(sel);
                        if (lane == r) { mylo = (unsigned)ms; myhi = (unsigned)(ms >> 32); }
                    }
                }
                if (lane < 32) { bm[(16 * sub + ql) * BMSTR + 2 * lane] = mylo; bm[(16 * sub + ql) * BMSTR + 2 * lane + 1] = myhi; }
            }
        }
#undef DSA_QLOAD
        __syncthreads();
        {
            const int head = wave >> 1, qh = wave & 1, t = q0 + 32 * qh + c;
            const size_t qrow = (size_t)b * SEQ + t;
            bf16x8 qf[4];
#pragma unroll
            for (int ks = 0; ks < 4; ++ks) qf[ks] = *(const bf16x8*)(QB + qrow * 256 + head * 64 + 16 * ks + 8 * hi);
            f32x16 Oa[2];
#pragma unroll
            for (int dt = 0; dt < 2; ++dt) Oa[dt] = zero16();
            float m = -1e30f, l = 0.f;
            const float bfar = brel[127 * 12 + head] * LOG2E;
            const LAS float* bh = brel + head;
            const int ntile = 2 * qb + qh + 1;
            bf16x8 kf[4], kn[4] = {}; u32x4 vr[4], vn[4] = {};
            { const size_t krow0 = (size_t)b * SEQ;
#pragma unroll
              for (int ks = 0; ks < 4; ++ks) kf[ks] = *(const bf16x8*)(KB + (krow0 + c) * 64 + 16 * ks + 8 * hi);
#pragma unroll
              for (int i = 0; i < 4; ++i) { const int id = lane + 64 * i, row = id >> 3, ch = id & 7; vr[i] = *(const u32x4*)(VB + (krow0 + row) * 64 + ch * 8); } }
            for (int kt = 0; kt < ntile; ++kt) {
#pragma unroll
                for (int i = 0; i < 4; ++i) { const int id = lane + 64 * i, row = id >> 3, ch = id & 7; *(LAS u32x4*)(wl + row * VSTR + ch * 16) = vr[i]; }
                if (kt + 1 < ntile) { const size_t krow1 = (size_t)b * SEQ + (kt + 1) * 32;
#pragma unroll
                    for (int ks = 0; ks < 4; ++ks) kn[ks] = *(const bf16x8*)(KB + (krow1 + c) * 64 + 16 * ks + 8 * hi);
#pragma unroll
                    for (int i = 0; i < 4; ++i) { const int id = lane + 64 * i, row = id >> 3, ch = id & 7; vn[i] = *(const u32x4*)(VB + (krow1 + row) * 64 + ch * 8); } }
                const unsigned word = bm[(32 * qh + c) * BMSTR + kt] >> (4 * hi);
                f32x16 S = zero16();
#pragma unroll
                for (int ks = 0; ks < 4; ++ks) S = __builtin_amdgcn_mfma_f32_32x32x16_bf16(kf[ks], qf[ks], S, 0, 0, 0);
                const bool far = (32 * kt + 31 + 113 <= q0 + 32 * qh);
                const int rb = t - 32 * kt - 4 * hi;
                float sv[16], tm = -1e30f;
#pragma unroll
                for (int r = 0; r < 16; ++r) { const int cr = (r & 3) + 8 * (r >> 2);
                    float bias = bfar;
                    if (!far) { int rel = rb - cr; rel = rel < 0 ? 0 : (rel > 127 ? 127 : rel); bias = bh[rel * 12] * LOG2E; }
                    const float v = S[r] * (0.125f * LOG2E) + bias;
                    const unsigned selbit = (word >> cr) & 1u;
                    const float cap = __builtin_bit_cast(float, 0xFF800000u ^ (selbit << 31));
                    sv[r] = fminf(v, cap); tm = fmaxf(tm, sv[r]); }
                const float mn = fmaxf(m, xhalf_max(tm));
                const float f = __builtin_amdgcn_exp2f(m - mn); m = mn;
                float p[16], ps = 0.f;
#pragma unroll
                for (int r = 0; r < 16; ++r) { p[r] = __builtin_amdgcn_exp2f(sv[r] - mn); ps += p[r]; }
                l = l * f + ps;
#pragma unroll
                for (int dt = 0; dt < 2; ++dt) Oa[dt] *= f;
                const bf16x8 pf0 = pack8(p), pf1 = pack8(p + 8);
                asm volatile("s_waitcnt lgkmcnt(0)" ::: "memory");
#pragma unroll
                for (int dt = 0; dt < 2; ++dt) { const LAS unsigned char* vp = wl + vb + dt * 64;
                    const bf16x8 v0 = mk8(vtr(vp), vtr(vp + 8 * VSTR)), v1 = mk8(vtr(vp + 16 * VSTR), vtr(vp + 24 * VSTR));
                    Oa[dt] = __builtin_amdgcn_mfma_f32_32x32x16_bf16(v0, pf0, Oa[dt], 0, 0, 0);
                    Oa[dt] = __builtin_amdgcn_mfma_f32_32x32x16_bf16(v1, pf1, Oa[dt], 0, 0, 0); }
                asm volatile("s_waitcnt lgkmcnt(0)" ::: "memory");
#pragma unroll
                for (int i = 0; i < 4; ++i) { kf[i] = kn[i]; vr[i] = vn[i]; }
            }
            const float il = 1.0f / xhalf_sum(l);
#pragma unroll
            for (int dt = 0; dt < 2; ++dt)
#pragma unroll
                for (int gg = 0; gg < 4; ++gg) { u32x2 w; w.x = cvt_pk_bf16(Oa[dt][4 * gg] * il, Oa[dt][4 * gg + 1] * il); w.y = cvt_pk_bf16(Oa[dt][4 * gg + 2] * il, Oa[dt][4 * gg + 3] * il);
                    *(u32x2*)(O + qrow * D + 256 + head * 64 + dt * 32 + 8 * gg + 4 * hi) = w; }
        }
      }
    }
}
#ifndef EN_MASK
#define EN_MASK 0xFFFFFFFFu
#endif
#define EN(k) (((EN_MASK) >> (k)) & 1u)
#ifndef DUPMASK
#define DUPMASK 0u
#endif
#define NREP(k) ((((DUPMASK) >> (k)) & 1u) ? 2 : 1)
#ifndef USE_DSA_MFMA
#define USE_DSA_MFMA 1
#endif
#ifndef USE_X_MFMA
#define USE_X_MFMA 1
#endif
#ifndef USE_SWA_MFMA
#define USE_SWA_MFMA 1
#endif
#ifndef USE_SB_MFMA
#define USE_SB_MFMA 1
#endif
#ifndef MK_ONE_LAUNCH
#define MK_ONE_LAUNCH 1
#endif
enum { I_X = 0, I_MEM, I_RELB, I_NMIX, I_WIN, I_BGATE, I_QNDSA, I_KNDSA, I_QNSWA, I_KNSWA, I_SINKS, I_WPA, I_WPB, I_WPC, I_WOUT, I_NX, I_NMEM, I_WXQ, I_WXKV, I_WXO, I_QNX, I_KNX, I_NFFN, I_WGUD, I_WDND, I_WR, I_WGUM, I_WDNM, N_INPUTS };
struct Args { const float* in[N_INPUTS]; float* out; unsigned char* ws; int ph_lo, ph_hi, pad0, pad1; };
constexpr int N_PHASES = 1 + 16 * DEPTH;

template <class AP> __device__ __forceinline__ bool get_cvt_job(AP ap, bf16_t* Wb, int j, CvtJob& J) {
    J.dff = 0; J.kd0 = 0; J.map = 0; J.ks = nullptr;
    if (j < 16) { const int l = j >> 3, k = j & 7;
        switch (k) {
        case 0: J.W = ap->in[I_WIN] + (size_t)l * D * NIN; J.K = D; J.Nsrc = NIN; J.Ndst = NINP; J.ldd = D; J.map = 1; J.WT = Wb + WO_IN + (size_t)l * NINP * D; break;
        case 1: J.W = ap->in[I_WPA] + (size_t)l * 256 * D; J.K = 256; J.Nsrc = D; J.Ndst = D; J.ldd = D; J.kd0 = 0;   J.WT = Wb + WO_P + (size_t)l * D * D; break;
        case 2: J.W = ap->in[I_WPB] + (size_t)l * 256 * D; J.K = 256; J.Nsrc = D; J.Ndst = D; J.ldd = D; J.kd0 = 256; J.WT = Wb + WO_P + (size_t)l * D * D; break;
        case 3: J.W = ap->in[I_WPC] + (size_t)l * 512 * D; J.K = 512; J.Nsrc = D; J.Ndst = D; J.ldd = D; J.kd0 = 512; J.WT = Wb + WO_P + (size_t)l * D * D; break;
        case 4: J.W = ap->in[I_WOUT] + (size_t)l * D * D;  J.K = D; J.Nsrc = D; J.Ndst = D; J.ldd = D; J.WT = Wb + WO_OUT + (size_t)l * D * D; break;
        case 5: J.W = ap->in[I_WXQ] + (size_t)l * D * 512; J.K = D; J.Nsrc = 512; J.Ndst = 512; J.ldd = D; J.WT = Wb + WO_XQ + (size_t)l * 512 * D; J.ks = ap->in[I_NX] + l * D; break;
        case 6: J.W = ap->in[I_WXKV] + (size_t)l * D * D;  J.K = D; J.Nsrc = D; J.Ndst = D; J.ldd = D; J.WT = Wb + WO_XKV + (size_t)l * D * D; break;
        default: J.W = ap->in[I_WXO] + (size_t)l * 512 * D; J.K = 512; J.Nsrc = D; J.Ndst = D; J.ldd = 512; J.WT = Wb + WO_XO + (size_t)l * D * 512; break;
        }
        return true; }
    if (j == 16) { J.W = ap->in[I_WGUD]; J.K = D; J.Nsrc = 2 * DFF; J.Ndst = 2 * DFF; J.ldd = D; J.map = 2; J.dff = DFF; J.WT = Wb + WO_GUD; return true; }
    if (j == 17) { J.W = ap->in[I_WDND]; J.K = DFF; J.Nsrc = D; J.Ndst = D; J.ldd = DFF; J.WT = Wb + WO_DND; return true; }
    if (j < 26) { const int e = j - 18; J.W = ap->in[I_WGUM] + (size_t)e * D * 2 * DFFE; J.K = D; J.Nsrc = 2 * DFFE; J.Ndst = 2 * DFFE; J.ldd = D; J.map = 2; J.dff = DFFE; J.WT = Wb + WO_GUM + (size_t)e * 2 * DFFE * D; return true; }
    if (j < 34) { const int e = j - 26; J.W = ap->in[I_WDNM] + (size_t)e * DFFE * D; J.K = DFFE; J.Nsrc = D; J.Ndst = D; J.ldd = DFFE; J.WT = Wb + WO_DNM + (size_t)e * D * DFFE; return true; }
    return false;
}

typedef const __attribute__((address_space(4))) Args* KArgs;
#define KA() ({ KArgs _p = (KArgs)__builtin_amdgcn_kernarg_segment_ptr(); asm volatile("" : "+s"(_p)); _p; })
#define PHASE_VARS \
    KArgs A = KA(); unsigned char* const ws = A->ws; (void)ws; \
    int tid = threadIdx.x; asm volatile("" : "+v"(tid)); \
    const int lane = tid & 63, wave = __builtin_amdgcn_readfirstlane(tid >> 6); \
    int G = gridDim.x, bx = blockIdx.x; asm volatile("" : "+s"(G), "+s"(bx)); \
    const int vcu = (G % 8 == 0) ? (bx % 8) * (G / 8) + bx / 8 : bx; \
    const int gw = vcu * NWAVES + wave, ngw = G * NWAVES; \
    const int gtid = vcu * NTHR + tid, gthreads = G * NTHR; \
    (void)lane; (void)wave; (void)gw; (void)ngw; (void)gtid; (void)gthreads; (void)vcu;
#define WSP(T_, off) ((T_*)(ws + (off)))
#define XS ((bf16_t*)A->out)
#define LDXS (2 * D)

__global__ void __launch_bounds__(NTHR, 2) mega_fwd(Args args_unused) {
    extern __shared__ __attribute__((aligned(16))) unsigned char lds_raw[];
    LAS unsigned char* lds = (LAS unsigned char*)lds_raw;
    for (int u = threadIdx.x; u < (LDS_BYTES - LDSCTL_OFF) / 4; u += NTHR) ((LAS unsigned*)(lds + LDSCTL_OFF))[u] = 0u;
    __syncthreads();
#if MK_ONE_LAUNCH
    XcdBarrier bar;
    { KArgs A0 = KA(); bar = xcd_barrier_post((unsigned*)(A0->ws + WS_CTL) + CW_BAR, (volatile LAS unsigned*)(lds + MISC_OFF) + 8); }
#define GRID_BAR() xcd_barrier(bar)
#else
#define GRID_BAR() do { } while (0)
#endif
#if MK_ONE_LAUNCH
    constexpr int lo = 0, hi = N_PHASES;
#else
    int lo, hi; { KArgs A0 = KA(); lo = A0->ph_lo; hi = A0->ph_hi; }
#endif
#define IN(k) (lo <= (k) && (k) < hi)
#define SEAM(k) do { if (IN(k) && (k) + 1 < hi) GRID_BAR(); } while (0)

    if (EN(0) && IN(0)) {
        PHASE_VARS
        LAS float* scr = (LAS float*)(lds + wave * 16384);
        bf16_t* Wb = WSP(bf16_t, WS_W);
        for (int rep = 0; rep < NREP(2); ++rep) {
        int base = 0;
        for (int j = 0; j < 34; ++j) { CvtJob J; get_cvt_job(A, Wb, j, J);
            const int nitems = (J.K / 64) * (J.Ndst / 32);
            int first = (gw - base) % ngw; if (first < 0) first += ngw;
            for (int it = first; it < nitems; it += ngw) cvt_item(J, scr, it, lane);
            base += nitems; }
        }
        for (int l = 0; l < DEPTH; ++l)
            norm_rows<0, false>(A->in[I_MEM], D, A->in[I_NMEM] + l * D, WSP(bf16_t, WS_MEMN) + (size_t)l * TM * D, TM, nullptr, 0, nullptr, gw, ngw, lane);
    }
    SEAM(0);

    for (int l = 0; l < DEPTH; ++l) {
        const int P = 1 + 16 * l;
        if (EN(1) && IN(P + 0)) {
            PHASE_VARS
            for (int rep = 0; rep < NREP(3); ++rep)
              if (l == 0) norm_rows<4, false>(A->in[I_X], D, A->in[I_NMIX] + l * D, WSP(bf16_t, WS_XN), T, A->in[I_WIN] + (size_t)l * D * NIN + 1472, NIN, WSP(float, WS_WI), gw, ngw, lane);
              else norm_rows<4, true>(XS, LDXS, A->in[I_NMIX] + l * D, WSP(bf16_t, WS_XN), T, A->in[I_WIN] + (size_t)l * D * NIN + 1472, NIN, WSP(float, WS_WI), gw, ngw, lane);
        }
        SEAM(P + 0);
        if (IN(P + 1)) {
            if (EN(2)) { PHASE_VARS
              pg8::SchedG1 S; S.init(WSP(bf16_t, WS_XN), WSP(bf16_t, WS_W) + WO_IN + (size_t)l * NINP * D, G, bx);
              pg8::EpiG1 E{WSP(bf16_t, WS_QKV), WSP(unsigned char, WS_GATES), A->in[I_BGATE] + l * NGATE, A->in[I_QNDSA] + l * 64, A->in[I_KNDSA] + l * 64, A->in[I_QNSWA] + l * 64, A->in[I_KNSWA] + l * 64};
              for (int rep = 0; rep < NREP(4); ++rep) pg8::gemm_phase<pg8::EpiG1, pg8::SchedG1>(lds, S, E, D, D); }
            if (EN(3) && l == 0) { PHASE_VARS
              pg8::SchedMemKV S; S.G = G; S.c = (bx + G / 2) % G; S.A = (const char*)WSP(bf16_t, WS_MEMN); S.B0 = (const char*)(WSP(bf16_t, WS_W) + WO_XKV); S.B1 = (const char*)(WSP(bf16_t, WS_W) + WO_XKV + (size_t)D * D);
              pg8::EpiBf16 E{WSP(bf16_t, WS_MEMKV), D};
              pg8::gemm_phase<pg8::EpiBf16, pg8::SchedMemKV>(lds, S, E, D, D); }
        }
        SEAM(P + 1);
        if (IN(P + 2)) {
            { PHASE_VARS
              LAS float* brel = (LAS float*)(lds + 148480);
              for (int i = tid; i < 128 * 12; i += NTHR) { const int rel = i / 12, c = i % 12; brel[i] = A->in[I_RELB][t5_bucket(rel) * 12 + c]; }
              __syncthreads();
              if (EN(4) && l == 0) memk_norm(WSP(bf16_t, WS_MEMKV), A->in[I_KNX], gw, ngw, lane); }
            if (EN(7)) { PHASE_VARS
              bf16_t* QKV = WSP(bf16_t, WS_QKV);
              for (int rep = 0; rep < NREP(12); ++rep) dsa_mfma(QKV + (size_t)T * 768, QKV + (size_t)T * 1024, QKV + (size_t)T * 1088, QKV + (size_t)T * 1152, QKV + (size_t)T * 1408, WSP(float, WS_WI), (LAS float*)(lds + 148480), WSP(bf16_t, WS_O), lds, vcu, G, tid);
              __syncthreads(); }
            if (EN(6)) { PHASE_VARS
              bf16_t* QKV = WSP(bf16_t, WS_QKV);
              for (int rep = 0; rep < NREP(10); ++rep) { swa_mfma(QKV + (size_t)T * 1472, QKV + (size_t)T * 1984, QKV + (size_t)T * 2112, A->in[I_SINKS] + l * 8, (LAS float*)(lds + 148480), WSP(bf16_t, WS_O), lds, vcu, G, tid); __syncthreads(); } }
            if (EN(5)) { PHASE_VARS
              bf16_t* QKV = WSP(bf16_t, WS_QKV);
              for (int rep = 0; rep < NREP(11); ++rep) sb_mfma(QKV, QKV + (size_t)T * 256, QKV + (size_t)T * 512, WSP(bf16_t, WS_O), lds + 65536 + wave * 6144, gw, ngw, lane);
              __syncthreads(); }
        }
        SEAM(P + 2);
        if (EN(8) && IN(P + 3)) {
            PHASE_VARS
            pg8::SchedRot S; S.init(WSP(bf16_t, WS_O), WSP(bf16_t, WS_W) + WO_P + (size_t)l * D * D, T, D, D, D, D, G, bx);
            pg8::EpiMerge E{WSP(unsigned char, WS_GATES), WSP(bf16_t, WS_MB)};
            for (int rep = 0; rep < NREP(8); ++rep) pg8::gemm_phase<pg8::EpiMerge, pg8::SchedRot>(lds, S, E, D, D);
        }
        SEAM(P + 3);
        if (EN(9) && IN(P + 4)) {
            PHASE_VARS
            pg8::SchedPlain S; S.init(WSP(bf16_t, WS_MB), WSP(bf16_t, WS_W) + WO_OUT + (size_t)l * D * D, T, D, D, D, D, G, bx);
            pg8::EpiResidB E{(l == 0) ? (const void*)A->in[I_X] : (const void*)XS, (l == 0) ? D : LDXS, (l == 0) ? 1 : 0, XS, LDXS};
            pg8::gemm_phase<pg8::EpiResidB, pg8::SchedPlain>(lds, S, E, D, D);
        }
        SEAM(P + 4);
        if (EN(11) && IN(P + 6)) {
            PHASE_VARS
            pg8::SchedPlain S; S.init(XS, WSP(bf16_t, WS_W) + WO_XQ + (size_t)l * 512 * D, T, 512, D, LDXS, D, G, bx);
            pg8::EpiBf16Rs E{WSP(bf16_t, WS_QX), 512, 1.0f / D};
            pg8::gemm_phase<pg8::EpiBf16Rs, pg8::SchedPlain>(lds, S, E, LDXS, D);
        }
        SEAM(P + 6);
        if (EN(12) && IN(P + 7)) {
            PHASE_VARS
#if USE_X_MFMA
            for (int rep = 0; rep < NREP(1); ++rep)
            xattn_mfma(WSP(bf16_t, WS_QX), WSP(bf16_t, WS_MEMKV) + (size_t)l * TM * D, A->in[I_QNX] + l * 128, WSP(bf16_t, WS_OX), lds, vcu, G, tid);
            __syncthreads();
#else
            xattn_naive(WSP(bf16_t, WS_QX), WSP(bf16_t, WS_MEMKV) + (size_t)l * TM * D, A->in[I_QNX] + l * 128, WSP(bf16_t, WS_OX), gw, ngw, lane);
#endif
        }
        SEAM(P + 7);
        if (EN(13) && IN(P + 8)) {
            PHASE_VARS
            pg8::SchedPlain S; S.init(WSP(bf16_t, WS_OX), WSP(bf16_t, WS_W) + WO_XO + (size_t)l * D * 512, T, D, 512, 512, 512, G, bx);
            pg8::EpiResidB E{XS, LDXS, 0, XS, LDXS};
            pg8::gemm_phase<pg8::EpiResidB, pg8::SchedPlain>(lds, S, E, 512, 512);
        }
        SEAM(P + 8);
        if (l == 0) {
            if (EN(14) && IN(P + 9)) { PHASE_VARS
                for (int rep = 0; rep < NREP(3); ++rep) norm_rows<0, true>(XS, LDXS, A->in[I_NFFN] + l * D, WSP(bf16_t, WS_XN), T, nullptr, 0, nullptr, gw, ngw, lane); }
            SEAM(P + 9);
            if (EN(15) && IN(P + 10)) {
                PHASE_VARS
                pg8::SchedPlain S; S.init(WSP(bf16_t, WS_XN), WSP(bf16_t, WS_W) + WO_GUD, T, 2 * DFF, D, D, D, G, bx);
                pg8::EpiSwiglu E{WSP(bf16_t, WS_ACTD), DFF};
                for (int rep = 0; rep < NREP(7); ++rep) pg8::gemm_phase<pg8::EpiSwiglu, pg8::SchedPlain>(lds, S, E, D, D);
            }
            SEAM(P + 10);
            if (EN(16) && IN(P + 11)) {
                PHASE_VARS
                pg8::SchedPlain S; S.init(WSP(bf16_t, WS_ACTD), WSP(bf16_t, WS_W) + WO_DND, T, D, DFF, DFF, DFF, G, bx);
                pg8::EpiResidB E{XS, LDXS, 0, XS, LDXS};
                pg8::gemm_phase<pg8::EpiResidB, pg8::SchedPlain>(lds, S, E, DFF, DFF);
            }
            if (IN(P + 11) && P + 16 < hi) GRID_BAR();
        } else {
            if (EN(17) && IN(P + 9)) { PHASE_VARS
                norm_router(XS, LDXS, A->in[I_NFFN] + l * D, WSP(bf16_t, WS_XN), A->in[I_WR], WSP(int, WS_TOKE), WSP(float, WS_TOKG), WSP(int, WS_CNT), (LAS int*)(lds + 1024), vcu, G, wave, lane); }
            SEAM(P + 9);
            if (EN(18) && IN(P + 10)) { PHASE_VARS
                moe_assign(WSP(int, WS_CNT), WSP(int, WS_TOKE), WSP(float, WS_TOKG), WSP(int, WS_TOKS), WSP(int, WS_STOK), WSP(float, WS_SGATE), WSP(int, WS_PBASE), WSP(bf16_t, WS_XN), WSP(bf16_t, WS_AG), (LAS int*)(lds + 1024), vcu, G, wave, lane); }
            SEAM(P + 10);
            if (EN(19) && IN(P + 11)) {
                PHASE_VARS
                pg8::SchedMoe S; S.init(WSP(bf16_t, WS_AG), WSP(bf16_t, WS_W) + WO_GUM, WSP(int, WS_PBASE), 2 * DFFE, D, G, bx);
                pg8::EpiSwiglu E{WSP(bf16_t, WS_ACTM), DFFE};
                for (int rep = 0; rep < NREP(5); ++rep) pg8::gemm_phase<pg8::EpiSwiglu, pg8::SchedMoe>(lds, S, E, D, D);
            }
            SEAM(P + 11);
            if (EN(20) && IN(P + 12)) {
                PHASE_VARS
                int nfull, tail, sp; pg8::moe_tail_split(WSP(int, WS_PBASE)[NEXP] * (D / 256), G, DFFE / 64, nfull, tail, sp);
                { pg8::SchedMoeMain S; S.init(WSP(bf16_t, WS_ACTM), WSP(bf16_t, WS_W) + WO_DNM, WSP(int, WS_PBASE), D, DFFE, G, bx); S.nfull = nfull;
                  pg8::EpiMoeDown E{WSP(bf16_t, WS_Y), WSP(float, WS_SGATE)};
                  pg8::gemm_phase<pg8::EpiMoeDown, pg8::SchedMoeMain>(lds, S, E, DFFE, DFFE); }
                { pg8::SchedMoeTail S; S.init(WSP(bf16_t, WS_ACTM), WSP(bf16_t, WS_W) + WO_DNM, WSP(int, WS_PBASE), D, DFFE, G, bx); S.init_tail(nfull, tail, sp);
                  pg8::EpiMoePart E{WSP(float, WS_PART), WSP(int, WS_TMAP), S.pidx, tail};
                  pg8::gemm_phase<pg8::EpiMoePart, pg8::SchedMoeTail>(lds, S, E, DFFE, DFFE); }
            }
            SEAM(P + 12);
            if (EN(21) && IN(P + 13)) { PHASE_VARS
                int nfull, tail, sp; pg8::moe_tail_split(WSP(int, WS_PBASE)[NEXP] * (D / 256), G, DFFE / 64, nfull, tail, sp);
                moe_combine(A->out, XS, LDXS, WSP(bf16_t, WS_Y), WSP(int, WS_TOKS), WSP(float, WS_SGATE), WSP(float, WS_PART), WSP(int, WS_TMAP), tail, sp, gw, ngw, lane); }
        }
    }
#undef IN
#undef SEAM
}


#ifndef DBG_CHECK
#define DBG_CHECK 0
#endif
#if DBG_CHECK
__global__ void dbg_diff(const bf16_t* a, const bf16_t* b, int rows, int ld, int c0, int nc, double* acc, int slot) {
    double d = 0, e = 0;
    for (long i = (long)blockIdx.x * blockDim.x + threadIdx.x; i < (long)rows * nc; i += (long)gridDim.x * blockDim.x) { const long r = i / nc, c = c0 + i % nc; const float x = bf2f(a[r * ld + c]), y = bf2f(b[r * ld + c]); d += (double)(x - y) * (x - y); e += (double)x * x; }
    for (int o = 32; o >= 1; o >>= 1) { d += __shfl_xor(d, o); e += __shfl_xor(e, o); }
    if ((threadIdx.x & 63) == 0) { atomicAdd(acc + 2 * slot, d); atomicAdd(acc + 2 * slot + 1, e); }
}
__global__ void dbg_emit(float* out, const double* acc, int nslots) { double mx = 0; for (int s = 0; s < nslots; ++s) { const double r = acc[2 * s + 1] > 0 ? acc[2 * s] / acc[2 * s + 1] : 1.0; mx = r > mx ? r : mx; } out[0] += (float)(1e8 * mx); }
__global__ void __launch_bounds__(NTHR, 2) dbg_attn(Args args_unused) {
    extern __shared__ __attribute__((aligned(16))) unsigned char lds_raw[];
    LAS unsigned char* lds = (LAS unsigned char*)lds_raw;
    PHASE_VARS
    const int mode = A->ph_lo, l = A->ph_hi;
    bf16_t* QKV = WSP(bf16_t, WS_QKV); bf16_t* OB2 = WSP(bf16_t, WS_MB);
    if (mode == 0) { xattn_mfma(WSP(bf16_t, WS_QX), WSP(bf16_t, WS_MEMKV) + (size_t)l * TM * D, A->in[I_QNX] + l * 128, WSP(bf16_t, WS_OX) + (size_t)T * 512, lds, vcu, G, tid); }
    else {
        LAS float* brel = (LAS float*)(lds + 148480);
        for (int i = tid; i < 128 * 12; i += NTHR) { const int rel = i / 12, c = i % 12; brel[i] = A->in[I_RELB][t5_bucket(rel) * 12 + c]; }
        __syncthreads();
        if (mode == 1) swa_mfma(QKV + (size_t)T * 1472, QKV + (size_t)T * 1984, QKV + (size_t)T * 2112, A->in[I_SINKS] + l * 8, brel, OB2, lds, vcu, G, tid);
        else sb_mfma(QKV, QKV + (size_t)T * 256, QKV + (size_t)T * 512, OB2, lds + 65536 + wave * 6144, gw, ngw, lane);
    }
}
#endif
extern "C" void kernel_launch(void* const* d_in, const int* in_sizes, int n_in, void* d_out, int out_size, void* d_ws, size_t ws_size, hipStream_t stream) {
    static int grid = 0;
    if (grid == 0) {
        if (n_in != N_INPUTS || out_size != T * D || ws_size < WS_END) { fprintf(stderr, "kernel_launch: unexpected problem (n_in %d, out %d, ws %zu)\n", n_in, out_size, ws_size); grid = -1; return; }
        int dev = 0, cus = 0, per_cu = 0;
        if (hipGetDevice(&dev) != hipSuccess || hipDeviceGetAttribute(&cus, hipDeviceAttributeMultiprocessorCount, dev) != hipSuccess) { grid = -1; return; }
        if (hipFuncSetAttribute((const void*)mega_fwd, hipFuncAttributeMaxDynamicSharedMemorySize, LDS_BYTES) != hipSuccess) { fprintf(stderr, "kernel_launch: hipFuncSetAttribute failed\n"); grid = -1; return; }
        if (hipOccupancyMaxActiveBlocksPerMultiprocessor(&per_cu, (const void*)mega_fwd, NTHR, LDS_BYTES) != hipSuccess || per_cu < 1) fprintf(stderr, "kernel_launch: occupancy query says %d\n", per_cu);
        (void)hipGetLastError();
        grid = cus;
    }
    if (grid < 0) return;
    (void)hipMemsetAsync((char*)d_ws + WS_CTL, 0, CTL_ZERO_BYTES, stream);
    Args a{};
    for (int i = 0; i < N_INPUTS; ++i) a.in[i] = (const float*)d_in[i];
    a.out = (float*)d_out; a.ws = (unsigned char*)d_ws; a.pad0 = 0; a.pad1 = 0;
#if MK_ONE_LAUNCH
    a.ph_lo = 0; a.ph_hi = N_PHASES;
    hipLaunchKernelGGL(mega_fwd, dim3(grid), dim3(NTHR), LDS_BYTES, stream, a);
#else
    for (int p = 0; p < N_PHASES; ++p) {
        const int l = (p - 1) / 16, k = (p - 1) % 16;
        if (p > 0) { if (l == 0 && k > 11) continue; if (l == 1 && k > 13) continue; }
        a.ph_lo = p; a.ph_hi = p + 1;
        hipLaunchKernelGGL(mega_fwd, dim3(grid), dim3(NTHR), LDS_BYTES, stream, a);
#if DBG_CHECK
        { static bool attr2 = false; if (!attr2) { (void)hipFuncSetAttribute((const void*)dbg_attn, hipFuncAttributeMaxDynamicSharedMemorySize, LDS_BYTES); attr2 = true; }
          double* acc = (double*)((char*)d_ws + WS_CTL + 512 * 1024);
          if (p > 0 && k == 2) {
              Args a2 = a; a2.ph_hi = l;
              a2.ph_lo = 1; hipLaunchKernelGGL(dbg_attn, dim3(grid), dim3(NTHR), LDS_BYTES, stream, a2);
              hipLaunchKernelGGL(dbg_diff, dim3(1024), dim3(256), 0, stream, (const bf16_t*)((char*)d_ws + WS_O), (const bf16_t*)((char*)d_ws + WS_MB), T, D, 512, 512, acc, 3 * l + 0);
              a2.ph_lo = 2; hipLaunchKernelGGL(dbg_attn, dim3(grid), dim3(NTHR), LDS_BYTES, stream, a2);
              hipLaunchKernelGGL(dbg_diff, dim3(1024), dim3(256), 0, stream, (const bf16_t*)((char*)d_ws + WS_O), (const bf16_t*)((char*)d_ws + WS_MB), T, D, 0, 256, acc, 3 * l + 1); }
          if (p > 0 && k == 7) { Args a2 = a; a2.ph_hi = l; a2.ph_lo = 0; hipLaunchKernelGGL(dbg_attn, dim3(grid), dim3(NTHR), LDS_BYTES, stream, a2);
              hipLaunchKernelGGL(dbg_diff, dim3(1024), dim3(256), 0, stream, (const bf16_t*)((char*)d_ws + WS_OX), (const bf16_t*)((char*)d_ws + WS_OX) + (size_t)T * 512, T, 512, 0, 512, acc, 3 * l + 2); }
          if (p == N_PHASES - 3) hipLaunchKernelGGL(dbg_emit, dim3(1), dim3(1), 0, stream, (float*)d_out, (const double*)acc, DBG_NSLOT); }
#endif
    }
#endif
}
```
